# Optimizing an MI355X kernel written in HIP

```python
import jax, jax.numpy as jnp
from jax import lax
import numpy as np

D_MODEL = 1024
BATCH = 16
SEQ = 2048
DEPTH = 4
DEC_BATCH = 128
DEC_SEQ = 1
PAST_LEN = 8192
PAGE_SIZE = 128

N_META = 16
N_A_LAYERS = DEPTH // 2
N_B_LAYERS = DEPTH - N_A_LAYERS
HG_HEADS = 8
HG_KDIM = 128
HG_VDIM = D_MODEL // HG_HEADS
HG_FDIM = HG_HEADS * HG_KDIM
HG_CHUNK = 64
LB_FLOOR = 1e-30
MLA_HEADS = 8
KV_LORA = 256
Q_LORA = 384
NOPE_DIM = 128
ROPE_DIM = 64
V_DIM = 128
ROPE_THETA = 10000.0
ATTN_SCALE = (NOPE_DIM + ROPE_DIM) ** -0.5
Q_BLOCK = 128
MASK_VALUE = -1e30
D_FF = 4 * D_MODEL
EPS = 1e-6

kernel_name = "yoco_hgrn2_mla_decoder_step"


def rmsnorm(x, g):
    xf = x.astype(jnp.float32)
    y = xf * lax.rsqrt(jnp.mean(xf * xf, axis=-1, keepdims=True) + EPS)
    return (y * g.astype(jnp.float32)).astype(x.dtype)


def sq_relu_mlp(x, w_up, w_down):
    h = jax.nn.relu(x @ w_up)
    return (h * h) @ w_down


def rope(x, pos):
    half = ROPE_DIM // 2
    inv_freq = ROPE_THETA ** (-jnp.arange(half, dtype=jnp.float32) / half)
    ang = pos.astype(jnp.float32)[:, None] * inv_freq[None, :]
    shape = (ang.shape[0],) + (1,) * (x.ndim - 3) + (half,)
    cos = jnp.cos(ang).reshape(shape)
    sin = jnp.sin(ang).reshape(shape)
    xf = x.astype(jnp.float32)
    x1, x2 = xf[..., :half], xf[..., half:]
    return jnp.concatenate([x1 * cos - x2 * sin, x2 * cos + x1 * sin], axis=-1).astype(x.dtype)


def hgrn2_chunk(S0, q, logf, k, v):
    L = q.shape[1]
    b = jnp.cumsum(logf, axis=1)
    causal = jnp.tril(jnp.ones((L, L), dtype=bool))[None, :, :, None, None]
    diff = b[:, :, None] - b[:, None, :]
    decay = jnp.where(causal, jnp.exp(jnp.where(causal, diff, 0.0)), 0.0)
    scores = jnp.einsum('bthk,btshk,bshk->bhts', q, decay, k)
    out = (jnp.einsum('bthk,bhkv->bthv', q * jnp.exp(b), S0)
           + jnp.einsum('bhts,bshv->bthv', scores, v))
    b_last = b[:, -1]
    S = (jnp.exp(b_last)[..., None] * S0
         + jnp.einsum('bshk,bshv->bhkv', k * jnp.exp(b_last[:, None] - b), v))
    return S, out


def hgrn2_recurrence(S0, q, logf, k, v, n_lead):
    Bsz, L = q.shape[0], q.shape[1]
    S, out_lead = hgrn2_chunk(S0, q[:, :n_lead], logf[:, :n_lead], k[:, :n_lead], v[:, :n_lead])
    rest = L - n_lead
    if rest == 0:
        return S, out_lead
    n_chunks = rest // HG_CHUNK

    def to_chunks(t):
        t = t[:, n_lead:]
        return jnp.moveaxis(t.reshape((Bsz, n_chunks, HG_CHUNK) + t.shape[2:]), 1, 0)

    S, out_rest = lax.scan(lambda s, c: hgrn2_chunk(s, c[0], c[1], c[2], c[3]), S,
                           (to_chunks(q), to_chunks(logf), to_chunks(k), to_chunks(v)))
    out_rest = jnp.moveaxis(out_rest, 0, 1).reshape(Bsz, rest, HG_HEADS, HG_VDIM)
    return S, jnp.concatenate([out_lead, out_rest], axis=1)


def hgrn2_mixer(xn, S0, w_q, w_f, w_i, w_g, g_norm, w_o, lb, n_lead):
    Bsz, L, _ = xn.shape
    f32 = jnp.float32
    hk = (Bsz, L, HG_HEADS, HG_KDIM)
    hv = (Bsz, L, HG_HEADS, HG_VDIM)
    q = jax.nn.silu((xn @ w_q).astype(f32)).reshape(hk)
    z = (xn @ w_f).astype(f32).reshape(hk)
    lbh = lb.reshape(HG_HEADS, HG_KDIM)
    logf = jnp.logaddexp(jnp.log1p(-lbh) + jax.nn.log_sigmoid(z),
                         jnp.log(jnp.maximum(lbh, LB_FLOOR)))
    k = (1.0 - lbh) * jax.nn.sigmoid(-z)
    v = (xn @ w_i).astype(f32).reshape(hv)
    S, o = hgrn2_recurrence(S0.astype(f32), q, logf, k, v, n_lead)
    o = rmsnorm(o, g_norm.reshape(HG_HEADS, HG_VDIM))
    o = o * jax.nn.silu((xn @ w_g).astype(f32)).reshape(hv)
    return o.reshape(Bsz, L, D_MODEL).astype(xn.dtype) @ w_o, S.astype(S0.dtype)


def shared_kv(h, pos, norm_kv, w_dkv, kv_norm, w_kr):
    hn = rmsnorm(h, norm_kv)
    ckv = rmsnorm(hn @ w_dkv, kv_norm)
    krope = rope(hn @ w_kr, pos)
    return ckv, krope


def mla_queries(xn, pos, w_dq, q_norm, w_uq, w_uk):
    cq = rmsnorm(xn @ w_dq, q_norm)
    q = jnp.einsum('bsr,rhd->bshd', cq, w_uq)
    q_nope = q[..., :NOPE_DIM]
    q_rope = rope(q[..., NOPE_DIM:], pos)
    q_lat = jnp.einsum('bshn,rhn->bshr', q_nope, w_uk)
    return q_lat, q_rope


def mla_output(o_lat, w_uv, w_o):
    Bsz, L = o_lat.shape[0], o_lat.shape[1]
    o = jnp.einsum('bshr,rhv->bshv', o_lat, w_uv)
    return o.reshape(Bsz, L, MLA_HEADS * V_DIM) @ w_o


def mla_scores(q_lat, q_rope, ckv, krope):
    s = jnp.einsum('bqhr,bkr->bhqk', q_lat, ckv) + jnp.einsum('bqhp,bkp->bhqk', q_rope, krope)
    return s.astype(jnp.float32) * ATTN_SCALE


def attend_dense(q_lat, q_rope, q_pos, ckv, krope, k_pos):
    s = mla_scores(q_lat, q_rope, ckv, krope)
    s = jnp.where((k_pos[None, :] <= q_pos[:, None])[None, None], s, MASK_VALUE)
    p = jax.nn.softmax(s, axis=-1).astype(ckv.dtype)
    return jnp.einsum('bhqk,bkr->bqhr', p, ckv)


def trunk(h, pos, hg_state0, n_lead, attend, p):
    lbs = jax.nn.softmax(p["hg_lower_bounds"].astype(jnp.float32), axis=0)
    lbs = jnp.cumsum(lbs, axis=0) - lbs[0]
    new_states = []
    ckv = krope = None
    for layer in range(DEPTH):
        xn = rmsnorm(h, p["norm_mix"][layer])
        if layer < N_A_LAYERS:
            mix, s_new = hgrn2_mixer(xn, hg_state0[layer], p["hg_wq"][layer], p["hg_wf"][layer],
                                     p["hg_wi"][layer], p["hg_wg"][layer], p["hg_gnorm"][layer],
                                     p["hg_wo"][layer], lbs[layer], n_lead)
            new_states.append(s_new)
        else:
            j = layer - N_A_LAYERS
            q_lat, q_rope = mla_queries(xn, pos, p["w_dq"][j], p["q_norm"][j], p["w_uq"][j], p["w_uk"])
            mix = mla_output(attend(q_lat, q_rope, pos, ckv, krope), p["w_uv"], p["w_o"][j])
        h = h + mix.astype(h.dtype)
        h = h + sq_relu_mlp(rmsnorm(h, p["norm_mlp"][layer]), p["w_up"][layer], p["w_down"][layer])
        if layer == N_A_LAYERS - 1:
            ckv, krope = shared_kv(h, pos, p["norm_kv"], p["w_dkv"], p["kv_norm"], p["w_kr"])
    return rmsnorm(h, p["norm_final"]), jnp.stack(new_states), ckv, krope


def setup_inputs(seed: int = 0) -> dict:
    key = jax.random.key(seed)
    ks = iter(jax.random.split(key, 40))
    f32 = jnp.float32

    def w(shape, fan_in):
        return jax.random.normal(next(ks), shape, f32) * (fan_in ** -0.5)

    def gain(shape):
        return 1.0 + 0.02 * jax.random.normal(next(ks), shape, f32)

    n_pages = PAST_LEN // PAGE_SIZE
    n_phys = (DEC_BATCH * n_pages * 5) // 4
    x_prompt = jax.random.normal(next(ks), (BATCH, SEQ, D_MODEL), f32)
    x_sample = jax.random.normal(next(ks), (DEC_BATCH, DEC_SEQ, D_MODEL), f32)
    state_hgrn = 0.5 * jax.random.normal(next(ks), (N_A_LAYERS, DEC_BATCH, HG_HEADS, HG_KDIM, HG_VDIM), f32)
    cache_ckv = jax.random.normal(next(ks), (n_phys, PAGE_SIZE, KV_LORA), f32)
    cache_krope = jax.random.normal(next(ks), (n_phys, PAGE_SIZE, ROPE_DIM), f32)
    page_table = jax.random.permutation(next(ks), n_phys)[: DEC_BATCH * n_pages].reshape(
        DEC_BATCH, n_pages).astype(jnp.int32)
    return {
        "x_prompt": x_prompt,
        "x_sample": x_sample,
        "state_hgrn": state_hgrn,
        "cache_ckv": cache_ckv,
        "cache_krope": cache_krope,
        "page_table": page_table,
        "meta_tokens": jax.random.normal(next(ks), (N_META, D_MODEL), f32),
        "norm_mix": gain((DEPTH, D_MODEL)),
        "norm_mlp": gain((DEPTH, D_MODEL)),
        "norm_final": gain((D_MODEL,)),
        "hg_wq": w((N_A_LAYERS, D_MODEL, HG_FDIM), D_MODEL),
        "hg_wf": w((N_A_LAYERS, D_MODEL, HG_FDIM), D_MODEL),
        "hg_wi": w((N_A_LAYERS, D_MODEL, D_MODEL), D_MODEL),
        "hg_wg": w((N_A_LAYERS, D_MODEL, D_MODEL), D_MODEL),
        "hg_gnorm": gain((N_A_LAYERS, D_MODEL)),
        "hg_wo": w((N_A_LAYERS, D_MODEL, D_MODEL), D_MODEL),
        "hg_lower_bounds": jax.random.normal(next(ks), (N_A_LAYERS, HG_FDIM), f32),
        "norm_kv": gain((D_MODEL,)),
        "w_dkv": w((D_MODEL, KV_LORA), D_MODEL),
        "kv_norm": gain((KV_LORA,)),
        "w_kr": w((D_MODEL, ROPE_DIM), D_MODEL),
        "w_uk": w((KV_LORA, MLA_HEADS, NOPE_DIM), KV_LORA),
        "w_uv": w((KV_LORA, MLA_HEADS, V_DIM), KV_LORA),
        "w_dq": w((N_B_LAYERS, D_MODEL, Q_LORA), D_MODEL),
        "q_norm": gain((N_B_LAYERS, Q_LORA)),
        "w_uq": w((N_B_LAYERS, Q_LORA, MLA_HEADS, NOPE_DIM + ROPE_DIM), Q_LORA),
        "w_o": w((N_B_LAYERS, MLA_HEADS * V_DIM, D_MODEL), MLA_HEADS * V_DIM),
        "w_up": w((DEPTH, D_MODEL, D_FF), D_MODEL),
        "w_down": w((DEPTH, D_FF, D_MODEL), D_FF),
    }


def reference(x_prompt, x_sample, state_hgrn, cache_ckv, cache_krope, page_table,
              meta_tokens, norm_mix, norm_mlp, norm_final,
              hg_wq, hg_wf, hg_wi, hg_wg, hg_gnorm, hg_wo, hg_lower_bounds,
              norm_kv, w_dkv, kv_norm, w_kr, w_uk, w_uv,
              w_dq, q_norm, w_uq, w_o, w_up, w_down):
    p = dict(norm_mix=norm_mix, norm_mlp=norm_mlp, norm_final=norm_final,
             hg_wq=hg_wq, hg_wf=hg_wf, hg_wi=hg_wi, hg_wg=hg_wg, hg_gnorm=hg_gnorm, hg_wo=hg_wo,
             hg_lower_bounds=hg_lower_bounds, norm_kv=norm_kv, w_dkv=w_dkv, kv_norm=kv_norm,
             w_kr=w_kr, w_uk=w_uk, w_uv=w_uv, w_dq=w_dq, q_norm=q_norm, w_uq=w_uq, w_o=w_o,
             w_up=w_up, w_down=w_down)

    b_p, seq = x_prompt.shape[0], x_prompt.shape[1]
    meta = jnp.broadcast_to(meta_tokens.astype(x_prompt.dtype)[None], (b_p, N_META, D_MODEL))
    h_p = jnp.concatenate([meta, x_prompt], axis=1)
    pos_p = jnp.arange(N_META + seq, dtype=jnp.int32)
    s0_p = jnp.zeros((N_A_LAYERS, b_p, HG_HEADS, HG_KDIM, HG_VDIM), jnp.float32)
    n_blk = seq // Q_BLOCK

    def prompt_attend(q_lat, q_rope, pos, ckv, krope):
        o_meta = attend_dense(q_lat[:, :N_META], q_rope[:, :N_META], pos[:N_META],
                              ckv[:, :N_META], krope[:, :N_META], pos[:N_META])

        def blocks(t):
            t = t[:, N_META:]
            return jnp.moveaxis(t.reshape((b_p, n_blk, Q_BLOCK) + t.shape[2:]), 1, 0)

        o = lax.map(lambda a: attend_dense(a[0], a[1], a[2], ckv, krope, pos),
                    (blocks(q_lat), blocks(q_rope), pos[N_META:].reshape(n_blk, Q_BLOCK)))
        o = jnp.moveaxis(o, 0, 1).reshape(b_p, seq, MLA_HEADS, KV_LORA)
        return jnp.concatenate([o_meta, o], axis=1)

    out_p, state_hgrn_prompt, ckv_prompt, krope_prompt = trunk(h_p, pos_p, s0_p, N_META, prompt_attend, p)
    y_prompt = out_p[:, N_META:]

    b_s, dec = x_sample.shape[0], x_sample.shape[1]
    pos_s = PAST_LEN + jnp.arange(dec, dtype=jnp.int32)
    ckv_past = cache_ckv[page_table].reshape(b_s, -1, KV_LORA)
    krope_past = cache_krope[page_table].reshape(b_s, -1, ROPE_DIM)
    n_past = ckv_past.shape[1]

    def sample_attend(q_lat, q_rope, pos, ckv_new, krope_new):
        s_past = mla_scores(q_lat, q_rope, ckv_past, krope_past)
        s_new = mla_scores(q_lat, q_rope, ckv_new, krope_new)
        s_new = jnp.where((pos[None, :] <= pos[:, None])[None, None], s_new, MASK_VALUE)
        pr = jax.nn.softmax(jnp.concatenate([s_past, s_new], axis=-1), axis=-1).astype(ckv_new.dtype)
        return (jnp.einsum('bhqk,bkr->bqhr', pr[..., :n_past], ckv_past)
                + jnp.einsum('bhqk,bkr->bqhr', pr[..., n_past:], ckv_new))

    y_sample, state_hgrn_sample, ckv_sample, krope_sample = trunk(x_sample, pos_s, state_hgrn, dec,
                                                                  sample_attend, p)
    return (y_prompt, y_sample, state_hgrn_prompt, ckv_prompt, krope_prompt,
            state_hgrn_sample, ckv_sample, krope_sample)
```

```cpp
#include <hip/hip_runtime.h>
#include <cstdio>
#include <cstdint>
#include <cmath>

#define GAS __attribute__((address_space(1)))
#define LAS __attribute__((address_space(3)))
typedef unsigned short bf16;
typedef unsigned v4u __attribute__((ext_vector_type(4)));
typedef unsigned v2u __attribute__((ext_vector_type(2)));
typedef float f32x4 __attribute__((ext_vector_type(4)));
typedef float f32x2 __attribute__((ext_vector_type(2)));
typedef short bf16x8 __attribute__((ext_vector_type(8)));
typedef short s16x4 __attribute__((ext_vector_type(4)));
typedef GAS unsigned gu32;
#define RLX_AGENT __ATOMIC_RELAXED, __HIP_MEMORY_SCOPE_AGENT

#ifndef PROBE_BUILD
#define PROBE_BUILD 0
#endif
#if PROBE_BUILD
#define AFLAGS (A.flags)
#else
#define AFLAGS 3
#endif
constexpr int D = 1024, NB = 16, T = 2048, NMETA = 16, NS = 128, FF = 4096;
constexpr int MAIN = NB * T;
constexpr int SIDE = MAIN;
constexpr int NSIDE = NMETA + NS;
constexpr int M = MAIN + 256;
constexpr int HH = 8, HK = 128, HV = 128;
constexpr int KVL = 256, QL = 384, NOPE = 128, ROPE = 64, VD = 128, PAST = 8192, PAGE = 128, NPG = PAST / PAGE;
constexpr float EPS = 1e-6f;
constexpr float ATT_C = 0.07216878364870322f * 1.4426950408889634f;
constexpr int LPROMPT = NMETA + T;
constexpr int ROPE_SLOTS = LPROMPT + 1;

constexpr size_t O_Y = 0, O_YS = O_Y + (size_t)NB * T * D, O_SP = O_YS + (size_t)NS * D, O_CKVP = O_SP + (size_t)2 * NB * HH * HK * HV,
                 O_KRP = O_CKVP + (size_t)NB * LPROMPT * KVL, O_SS = O_KRP + (size_t)NB * LPROMPT * ROPE, O_CKVS = O_SS + (size_t)2 * NS * HH * HK * HV,
                 O_KRS = O_CKVS + (size_t)NS * KVL, O_END = O_KRS + (size_t)NS * ROPE;
static_assert(O_END == 82042880, "output size");

constexpr size_t al(size_t x) { return (x + 4095) & ~(size_t)4095; }
constexpr size_t WS_CTL = 0, CTL_BYTES = 1u << 20;
constexpr size_t WS_WIN = WS_CTL + CTL_BYTES;
constexpr size_t WS_WHO = WS_WIN + (size_t)2 * 4096 * 1024 * 2;
constexpr size_t WS_WUP = WS_WHO + (size_t)2 * 1024 * 1024 * 2;
constexpr size_t WS_WDN = WS_WUP + (size_t)4 * 4096 * 1024 * 2;
constexpr size_t WS_WKVQ = WS_WDN + (size_t)4 * 4096 * 1024 * 2;
constexpr size_t WS_WDQ1 = WS_WKVQ + (size_t)768 * 1024 * 2;
constexpr size_t WS_WUQ = WS_WDQ1 + (size_t)512 * 1024 * 2;
constexpr size_t WS_WO = WS_WUQ + (size_t)2 * 1536 * 384 * 2;
constexpr size_t WS_WUKV = WS_WO + (size_t)2 * 1024 * 1024 * 2;
constexpr size_t WS_ROPE = al(WS_WUKV + (size_t)2048 * 256 * 2);
constexpr size_t WS_LBT = al(WS_ROPE + (size_t)ROPE_SLOTS * 64 * 4);
constexpr size_t WS_SS = al(WS_LBT + (size_t)2 * 3 * 1024 * 4);
constexpr int NSS = 12;
constexpr size_t WS_H = al(WS_SS + (size_t)NSS * M * 4);
constexpr size_t WS_HB = al(WS_H + (size_t)M * D * 4);
constexpr size_t WS_QB = al(WS_HB + (size_t)M * D * 2);
constexpr size_t WS_KB = al(WS_QB + (size_t)M * D * 2);
constexpr size_t WS_VB = al(WS_KB + (size_t)M * D * 2);
constexpr size_t WS_GB = al(WS_VB + (size_t)M * D * 2);
constexpr size_t WS_LF = al(WS_GB + (size_t)M * D * 2);
constexpr size_t WS_ORAW = al(WS_LF + (size_t)M * D * 4);
constexpr size_t WS_OB = al(WS_ORAW + (size_t)M * D * 4);
constexpr size_t WS_HID = al(WS_OB + (size_t)M * D * 2);
constexpr size_t WS_CKVF = al(WS_HID + (size_t)M * FF * 2);
constexpr size_t WS_CKVB = al(WS_CKVF + (size_t)M * KVL * 4);
constexpr size_t WS_KRF = al(WS_CKVB + (size_t)M * KVL * 2);
constexpr size_t WS_KRB = al(WS_KRF + (size_t)M * ROPE * 4);
constexpr size_t WS_CQB = al(WS_KRB + (size_t)M * ROPE * 2);
constexpr size_t WS_QN = al(WS_CQB + (size_t)M * QL * 2);
constexpr size_t WS_QR = al(WS_QN + (size_t)M * D * 2);
constexpr size_t WS_KN = al(WS_QR + (size_t)M * 512 * 2);
constexpr size_t WS_VV = al(WS_KN + (size_t)M * D * 2);
constexpr size_t WS_AO = al(WS_VV + (size_t)M * D * 2);
constexpr size_t WS_PART = al(WS_AO + (size_t)M * D * 2);
constexpr size_t WS_SSP = al(WS_PART + (size_t)2 * NS * 4 * 2112 * 4);
constexpr size_t WS_SSPS = al(WS_SSP + (size_t)12 * 32768 * 16 * 4);
constexpr size_t WS_END = al(WS_SSPS + (size_t)12 * 256 * 64 * 4);
enum { SS_H0 = 0, SS_CKV = 9, SS_CQ0 = 10, SS_CQ1 = 11 };

constexpr int RING_BYTES = 131072, LDSCTL_OFF = RING_BYTES, LDS_BYTES = 147456;

#define LDS_WAIT() asm volatile("s_waitcnt lgkmcnt(0)" ::: "memory")
#define VM_WAIT() asm volatile("s_waitcnt vmcnt(0)" ::: "memory")
__device__ __forceinline__ unsigned f2bf(float f) { unsigned u = __builtin_bit_cast(unsigned, f); return (u + 0x7fffu + ((u >> 16) & 1u)) >> 16; }
typedef __bf16 bf16x2_t __attribute__((ext_vector_type(2)));
__device__ __forceinline__ unsigned pk2(float lo, float hi) { const f32x2 v = {lo, hi}; return __builtin_bit_cast(unsigned, __builtin_convertvector(v, bf16x2_t)); }
__device__ __forceinline__ float bf2f(unsigned short b) { return __builtin_bit_cast(float, (unsigned)b << 16); }
__device__ __forceinline__ float bflo(unsigned w) { return __builtin_bit_cast(float, w << 16); }
__device__ __forceinline__ float bfhi(unsigned w) { return __builtin_bit_cast(float, w & 0xffff0000u); }
__device__ __forceinline__ float rstd_of(float ss, float inv_n) { return __builtin_amdgcn_rsqf(ss * inv_n + EPS); }
__device__ __forceinline__ int pos_slot(int row) { return row < MAIN ? NMETA + (row & (T - 1)) : (row - SIDE < NMETA ? row - SIDE : (row - SIDE < NSIDE ? LPROMPT : 0)); }
__device__ __forceinline__ int lane_id_v() { int l; asm volatile("v_mbcnt_lo_u32_b32 %0, -1, 0\n\tv_mbcnt_hi_u32_b32 %0, -1, %0" : "=v"(l)); return l; }
__device__ __forceinline__ f32x4 mfma16(bf16x8 a, bf16x8 b, f32x4 c) { return __builtin_amdgcn_mfma_f32_16x16x32_bf16(a, b, c, 0, 0, 0); }
__device__ __forceinline__ s16x4 tr_rd(LAS unsigned char* p) { return __builtin_amdgcn_ds_read_tr16_b64_v4i16((LAS s16x4*)p); }
__device__ __forceinline__ bf16x8 cat4(s16x4 lo, s16x4 hi) { bf16x8 r = {lo[0], lo[1], lo[2], lo[3], hi[0], hi[1], hi[2], hi[3]}; return r; }
__device__ __forceinline__ bf16x8 pack8(f32x4 a, f32x4 b) { v4u w; w.x = pk2(a[0], a[1]); w.y = pk2(a[2], a[3]); w.z = pk2(b[0], b[1]); w.w = pk2(b[2], b[3]); return __builtin_bit_cast(bf16x8, w); }
__device__ __forceinline__ float max4(f32x4 v) { return fmaxf(fmaxf(v[0], v[1]), fmaxf(v[2], v[3])); }
constexpr float NEG = -1e30f;

template <int N> __device__ __forceinline__ float dpp_ror(float x) { return __builtin_bit_cast(float, __builtin_amdgcn_update_dpp(0, __builtin_bit_cast(int, x), 0x120 + N, 0xf, 0xf, false)); }
__device__ __forceinline__ float row_sum16(float x) { x += dpp_ror<8>(x); x += dpp_ror<4>(x); x += dpp_ror<2>(x); x += dpp_ror<1>(x); return x; }
__device__ __forceinline__ float u2f(unsigned u) { return __builtin_bit_cast(float, u); }
__device__ __forceinline__ unsigned f2u(float f) { return __builtin_bit_cast(unsigned, f); }
__device__ __forceinline__ float xg_max(float x) {
    auto s = __builtin_amdgcn_permlane16_swap(f2u(x), f2u(x), false, false); const unsigned s0 = s[0], s1 = s[1];
    x = fmaxf(u2f(s0), u2f(s1));
    auto t = __builtin_amdgcn_permlane32_swap(f2u(x), f2u(x), false, false); const unsigned t0 = t[0], t1 = t[1];
    return fmaxf(u2f(t0), u2f(t1));
}
__device__ __forceinline__ float xg_sum(float x) {
    auto s = __builtin_amdgcn_permlane16_swap(f2u(x), f2u(x), false, false); const unsigned s0 = s[0], s1 = s[1];
    x = u2f(s0) + u2f(s1);
    auto t = __builtin_amdgcn_permlane32_swap(f2u(x), f2u(x), false, false); const unsigned t0 = t[0], t1 = t[1];
    return u2f(t0) + u2f(t1);
}
__device__ __forceinline__ float half_sum(float x) {
    auto t = __builtin_amdgcn_permlane32_swap(f2u(x), f2u(x), false, false); const unsigned t0 = t[0], t1 = t[1];
    return u2f(t0) + u2f(t1);
}
__device__ __forceinline__ float row_scan4(float x, int row) {
    auto s = __builtin_amdgcn_permlane16_swap(f2u(x), f2u(x), false, false); const unsigned s0 = s[0], s1 = s[1];
    const float y = (row & 1) ? u2f(s0) + u2f(s1) : x;
    auto t = __builtin_amdgcn_permlane32_swap(f2u(y), f2u(y), false, false); const unsigned t0 = t[0];
    auto u = __builtin_amdgcn_permlane16_swap(t0, t0, false, false); const unsigned u1 = u[1];
    return (row & 2) ? y + u2f(u1) : y;
}
struct SSR { const float* m; const float* s; };
struct SSW { float* m; float* s; };
__device__ __forceinline__ float ss_get(const SSR r, int row) {
    if (row < SIDE) { const f32x4* p = (const f32x4*)(r.m + (size_t)row * 16); const f32x4 a = p[0] + p[1], b = p[2] + p[3]; const f32x4 c = a + b; return (c[0] + c[1]) + (c[2] + c[3]); }
    const f32x4* p = (const f32x4*)(r.s + (size_t)(row - SIDE) * 64); f32x4 c = p[0];
#pragma unroll
    for (int i = 1; i < 16; ++i) c += p[i];
    return (c[0] + c[1]) + (c[2] + c[3]);
}
#define XB_TMO      128
#define XB_XCNT(j)  (256  + 64 * (j))
#define XB_XSUB(j)  (1280 + 64 * (j))
#define XB_XGEN(j)  (2304 + 64 * (j))
#define XB_TOP      3328
#define XB_TOPGEN   3392
#define XCD_BAR_WORDS 3456
#define XB_SPIN_CAP (1u << 18)

__device__ __forceinline__ unsigned xb_ld(unsigned* p)              { return __hip_atomic_load(p, __ATOMIC_RELAXED, __HIP_MEMORY_SCOPE_AGENT); }
__device__ __forceinline__ unsigned xb_add(unsigned* p, unsigned v) { return __hip_atomic_fetch_add(p, v, __ATOMIC_RELAXED, __HIP_MEMORY_SCOPE_AGENT); }
__device__ __forceinline__ unsigned xb_xcc_id() { return (unsigned)__builtin_amdgcn_s_getreg((3 << 11) | 20) & 0xFu; }
#define XB_SPIN(cond, bar) do { unsigned _sp = 0; while (cond) { __builtin_amdgcn_s_sleep(1); \
    if ((++_sp & 255u) == 0u) { if (xb_ld(&(bar)[XB_TMO])) break; if (_sp > XB_SPIN_CAP) { atomicAdd(&(bar)[XB_TMO], 1u); break; } } } } while (0)

struct XcdBarrier {
    unsigned* bar; unsigned x;
    volatile LAS unsigned* st;
};

__device__ __forceinline__ XcdBarrier xcd_barrier_post(unsigned* bar, volatile LAS unsigned* st) {
    XcdBarrier b; b.bar = bar; b.x = xb_xcc_id(); b.st = st;
    if (threadIdx.x == 0) (void)xb_add(&bar[XB_XCNT(b.x)], 1u);
    return b;
}
__device__ __forceinline__ void xcd_barrier_complete(unsigned* bar, unsigned x, unsigned& nloc, unsigned& nx) {
    const unsigned G = gridDim.x * gridDim.y * gridDim.z;
    unsigned sum, cnt, mine, sp = 0u;
    for (;;) {
        sum = 0u; cnt = 0u; mine = 0u;
#pragma unroll
        for (unsigned j = 0; j < 16; ++j) { const unsigned c = xb_ld(&bar[XB_XCNT(j)]); sum += c; cnt += (c > 0u) ? 1u : 0u; mine = (j == x) ? c : mine; }
        if (sum == G) break;
        __builtin_amdgcn_s_sleep(1);
        if ((++sp & 255u) == 0u) { if (xb_ld(&bar[XB_TMO])) break; if (sp > XB_SPIN_CAP) { atomicAdd(&bar[XB_TMO], 1u); break; } }
    }
    nloc = mine > 0u ? mine : 1u; nx = cnt > 0u ? cnt : 1u;
}

__device__ __forceinline__ void xcd_barrier(const XcdBarrier& b) {
    asm volatile("s_waitcnt vmcnt(0)" ::: "memory");
    __syncthreads();
    if (threadIdx.x == 0) {
        unsigned* bar = b.bar;
        __builtin_amdgcn_s_waitcnt(0);
        unsigned nloc = b.st[0], nx = b.st[1];
        if (nloc == 0u) { xcd_barrier_complete(bar, b.x, nloc, nx); b.st[0] = nloc; b.st[1] = nx; }
        const unsigned old = xb_add(&bar[XB_XSUB(b.x)], 1u);
        const unsigned gen = old / nloc;
        if (old + 1u == (gen + 1u) * nloc) {
            __builtin_amdgcn_fence(__ATOMIC_RELEASE, "agent");
            asm volatile("s_waitcnt vmcnt(0)" ::: "memory");
            const unsigned og = xb_add(&bar[XB_TOP], 1u);
            const unsigned tg = og / nx;
            if (og + 1u == (tg + 1u) * nx) xb_add(&bar[XB_TOPGEN], 1u);
            else XB_SPIN(xb_ld(&bar[XB_TOPGEN]) == tg, bar);
            __builtin_amdgcn_fence(__ATOMIC_ACQUIRE, "agent");
            xb_add(&bar[XB_XGEN(b.x)], 1u);
            asm volatile("s_waitcnt vmcnt(0)" ::: "memory");
        } else {
            XB_SPIN(xb_ld(&bar[XB_XGEN(b.x)]) == gen, bar);
            __builtin_amdgcn_fence(__ATOMIC_ACQUIRE, "agent");
            asm volatile("s_waitcnt vmcnt(0)" ::: "memory");
        }
    }
    __syncthreads();
}
namespace pg8 {
#define PG8_LAS __attribute__((address_space(3)))
typedef unsigned short bf16_t;
typedef short bf16x8 __attribute__((ext_vector_type(8)));
typedef float f32x4 __attribute__((ext_vector_type(4)));
typedef unsigned u32x4 __attribute__((ext_vector_type(4)));
constexpr int BM = 256, BK = 64, HALF = 128, HTB = HALF * BK * 2  , STAGE_BYTES = 8 * HTB, NXCD = 8, WGM = 8;

__host__ __device__ __forceinline__ int lds_byte(int r, int c) { const int st = (r >> 4) * 2 + (c >> 5), rr = r & 15, cc = c & 31, ob = rr * 64 + cc * 2; return st * 1024 + (ob ^ (((ob >> 9) & 1) << 5)); }
__host__ __device__ __forceinline__ void stage_rc(int b, int& R, int& C) { const int st = b / 1024, sb = b % 1024, swz = sb ^ (((sb >> 9) & 1) << 5); R = (st >> 1) * 16 + swz / 64; C = (st & 1) * 32 + (swz % 64) / 2; }
__host__ __device__ __forceinline__ int perm32(int rho) { const int n = rho >> 4, i = rho & 15; return 8 * (i >> 2) + 4 * n + (i & 3); }
__host__ __device__ __forceinline__ int perm256(int R) { const int wc = R >> 5, n = (R >> 4) & 1, i = R & 15; return 64 * wc + 16 * (i >> 2) + 4 * n + (i & 3); }

struct Unit { int pm, pn; };
struct Gemm { const bf16_t* A; const bf16_t* Bt; int M, N, K; };

struct StaticOrder {
    int nM, nN, nwg, G, c;
    __host__ __device__ void init(int M, int N, int G_, int c_) { nM = M / BM; nN = N / BM; nwg = nM * nN; G = G_; c = c_; }
    __host__ __device__ bool next(int i, Unit& u) const {
        const long L = (long)i * G + c; if (L >= nwg) return false;
        int wgid = (int)L; { const int q = nwg / NXCD, r = nwg % NXCD, xcd = wgid % NXCD, off = wgid / NXCD; wgid = (xcd < r ? xcd * (q + 1) : r * (q + 1) + (xcd - r) * q) + off; }
        const int nig = WGM * nN, gid = wgid / nig, fm = gid * WGM, gsz = (nM - fm) < WGM ? (nM - fm) : WGM;
        u.pm = fm + ((wgid % nig) % gsz); u.pn = (wgid % nig) / gsz; return true;
    }
    __device__ __forceinline__ void a_ready(const Unit&) const {}
    __device__ __forceinline__ void done(const Unit&) const {}
};

template <class Epi, class Sched, bool ALIGN_EPI = false, bool SP2 = false>
__device__ __forceinline__ void gemm_phase(PG8_LAS unsigned char* lds, const Gemm g, const Sched& S, const Epi& E, const int wave_sgpr) {
    int tid_ = wave_sgpr * 64 + lane_id_v();
    const int tid = tid_, wid = __builtin_amdgcn_readfirstlane(tid >> 6), lane = tid & 63, wr = wid >> 2, wc = wid & 3, fr = lane & 15, fq = lane >> 4;
    const int K = g.K, nt = K / BK;
    unsigned voffA[2], voffB[2];
#pragma unroll
    for (int i = 0; i < 2; ++i) { int R, C; stage_rc(tid * 16 + i * 8192, R, C); const int Rb = Epi::PERM ? perm256(R) : R;
        voffA[i] = (unsigned)(R * K + C) * 2u; voffB[i] = (unsigned)(Rb * K + C) * 2u; }
    const size_t kstep = (size_t)(BK * 2);
    const size_t hstep = (size_t)HALF * K * 2;
    const size_t hstepB = Epi::PERM ? (size_t)8 * K * 2 : hstep;
    const size_t tstep = 2 * hstep;
    const unsigned ldsw = (unsigned)wid * 1024u;
    const int aoff = lds_byte(wr * 64 + fr, fq * 8), boff = lds_byte(wc * 32 + fr, fq * 8);
#define PG8_SA(b, h) (((b) * 2 + (h)) * HTB)
#define PG8_SB(b, h) ((4 + (b) * 2 + (h)) * HTB)
#define PG8_STAGE(bufoff, gbase, voff) do { _Pragma("unroll") for (int _i = 0; _i < 2; ++_i) \
        __builtin_amdgcn_global_load_lds((const unsigned*)((const char*)(gbase) + (voff)[_i]), (PG8_LAS unsigned*)(lds + (bufoff) + ldsw + _i * 8192), 16, 0, 0); } while (0)
#define PG8_LDA(dst, b, h) do { _Pragma("unroll") for (int m = 0; m < 4; ++m) _Pragma("unroll") for (int k = 0; k < 2; ++k) dst[m][k] = *(const PG8_LAS bf16x8*)(lds + PG8_SA(b, h) + aoff + m * 2048 + k * 1024); } while (0)
#define PG8_LDB(dst, b, h) do { _Pragma("unroll") for (int n = 0; n < 2; ++n) _Pragma("unroll") for (int k = 0; k < 2; ++k) dst[n][k] = *(const PG8_LAS bf16x8*)(lds + PG8_SB(b, h) + boff + n * 2048 + k * 1024); } while (0)
#define PG8_MMA(ai, bj, At, Bt) do { __builtin_amdgcn_s_setprio(1); _Pragma("unroll") for (int m = 0; m < 4; ++m) _Pragma("unroll") for (int n = 0; n < 2; ++n) _Pragma("unroll") for (int k = 0; k < 2; ++k) \
        acc[ai][bj][m][n] = __builtin_amdgcn_mfma_f32_16x16x32_bf16(Bt[n][k], At[m][k], acc[ai][bj][m][n], 0, 0, 0); __builtin_amdgcn_s_setprio(0); } while (0)
#define PG8_WAIT_V(n) asm volatile("s_waitcnt vmcnt(" #n ")" ::: "memory")
#define PG8_WAIT_L(n) asm volatile("s_waitcnt lgkmcnt(" #n ")" ::: "memory")
#define PG8_BAR __builtin_amdgcn_s_barrier()
#define PG8_SCHED __builtin_amdgcn_sched_barrier(0)
    Unit cur, nxt; int ui = 0;
    if (!S.next(0, cur)) return;
    f32x4 acc[2][2][4][2];
#pragma unroll
    for (int a = 0; a < 2; ++a)
#pragma unroll
        for (int b = 0; b < 2; ++b)
#pragma unroll
            for (int m = 0; m < 4; ++m)
#pragma unroll
                for (int n = 0; n < 2; ++n) acc[a][b][m][n] = (f32x4){0.f, 0.f, 0.f, 0.f};
    bf16x8 At[4][2], B0[2][2], B1[2][2];
    const char* cA = (const char*)g.A + (size_t)cur.pm * tstep; const char* cB = (const char*)g.Bt + (size_t)cur.pn * tstep;
    S.a_ready(cur);
    if constexpr (SP2) {
        PG8_STAGE(PG8_SB(0, 0), cB, voffB); PG8_STAGE(PG8_SB(0, 1), cB + hstepB, voffB); PG8_STAGE(PG8_SA(0, 0), cA, voffA); PG8_STAGE(PG8_SA(0, 1), cA + hstep, voffA);
        if (wr == 1) PG8_BAR;
        PG8_WAIT_V(2); PG8_BAR;
        PG8_STAGE(PG8_SB(1, 0), cB + kstep, voffB); PG8_STAGE(PG8_SA(1, 0), cA + kstep, voffA); PG8_STAGE(PG8_SB(1, 1), cB + hstepB + kstep, voffB);
        PG8_WAIT_V(6); PG8_BAR;
    } else {
        PG8_STAGE(PG8_SB(0, 0), cB, voffB); PG8_STAGE(PG8_SA(0, 0), cA, voffA); PG8_STAGE(PG8_SB(0, 1), cB + hstepB, voffB); PG8_STAGE(PG8_SA(0, 1), cA + hstep, voffA);
        if (wr == 1) PG8_BAR;
        PG8_WAIT_V(4); PG8_BAR;
        PG8_STAGE(PG8_SB(1, 0), cB + kstep, voffB); PG8_STAGE(PG8_SA(1, 0), cA + kstep, voffA); PG8_STAGE(PG8_SB(1, 1), cB + hstepB + kstep, voffB);
        PG8_WAIT_V(6); PG8_BAR;
    }
    for (;;) {
        const bool has_next = S.next(ui + 1, nxt);
        const char* nA = has_next ? (const char*)g.A + (size_t)nxt.pm * tstep : cA; const char* nB = has_next ? (const char*)g.Bt + (size_t)nxt.pn * tstep : cB;
        for (int t = 0; t < nt; t += 2) {
            const bool last = (t == nt - 2);
            const char* a1 = cA + (size_t)(t + 1) * kstep;
            const char* a2 = last ? nA : cA + (size_t)(t + 2) * kstep; const char* b2 = last ? nB : cB + (size_t)(t + 2) * kstep;
            const char* a3 = a2 + kstep; const char* b3 = b2 + kstep;
            if (last && has_next) S.a_ready(nxt);
            if constexpr (SP2) {
            PG8_LDB(B0, 0, 0); PG8_LDB(B1, 0, 1); PG8_SCHED; PG8_LDA(At, 0, 0); PG8_STAGE(PG8_SA(1, 1), a1 + hstep, voffA);
            PG8_WAIT_V(8); PG8_WAIT_L(0); PG8_BAR; PG8_MMA(0, 0, At, B0); PG8_MMA(0, 1, At, B1); PG8_BAR; PG8_SCHED;
            PG8_LDA(At, 0, 1); PG8_STAGE(PG8_SB(0, 0), b2, voffB); PG8_STAGE(PG8_SB(0, 1), b2 + hstepB, voffB); PG8_STAGE(PG8_SA(0, 0), a2, voffA);
            PG8_WAIT_V(8); PG8_WAIT_L(0); PG8_BAR; PG8_MMA(1, 0, At, B0); PG8_MMA(1, 1, At, B1); PG8_BAR; PG8_SCHED;
            PG8_LDB(B0, 1, 0); PG8_LDB(B1, 1, 1); PG8_SCHED; PG8_LDA(At, 1, 0); PG8_STAGE(PG8_SA(0, 1), a2 + hstep, voffA);
            PG8_WAIT_V(8); PG8_WAIT_L(0); PG8_BAR; PG8_MMA(0, 0, At, B0); PG8_MMA(0, 1, At, B1); PG8_BAR; PG8_SCHED;
            PG8_LDA(At, 1, 1); PG8_STAGE(PG8_SB(1, 0), b3, voffB); PG8_STAGE(PG8_SB(1, 1), b3 + hstepB, voffB); PG8_STAGE(PG8_SA(1, 0), a3, voffA);
            PG8_WAIT_V(8); PG8_WAIT_L(0); PG8_BAR; PG8_MMA(1, 0, At, B0); PG8_MMA(1, 1, At, B1); PG8_BAR; PG8_SCHED;
            } else {
            PG8_LDB(B0, 0, 0); PG8_SCHED; PG8_LDA(At, 0, 0); PG8_STAGE(PG8_SA(1, 1), a1 + hstep, voffA);
            PG8_WAIT_L(8); PG8_BAR; PG8_WAIT_L(0); PG8_MMA(0, 0, At, B0); PG8_BAR; PG8_SCHED;
            PG8_LDB(B1, 0, 1); PG8_STAGE(PG8_SB(0, 0), b2, voffB);
            PG8_BAR; PG8_WAIT_L(0); PG8_MMA(0, 1, At, B1); PG8_BAR;
            PG8_LDA(At, 0, 1); PG8_STAGE(PG8_SA(0, 0), a2, voffA);
            PG8_BAR; PG8_WAIT_L(0); PG8_MMA(1, 0, At, B0); PG8_BAR; PG8_SCHED;
            PG8_STAGE(PG8_SB(0, 1), b2 + hstepB, voffB);
            PG8_WAIT_V(6); PG8_BAR; PG8_MMA(1, 1, At, B1); PG8_BAR;
            PG8_LDB(B0, 1, 0); PG8_SCHED; PG8_LDA(At, 1, 0); PG8_STAGE(PG8_SA(0, 1), a2 + hstep, voffA);
            PG8_WAIT_L(8); PG8_BAR; PG8_WAIT_L(0); PG8_MMA(0, 0, At, B0); PG8_BAR; PG8_SCHED;
            PG8_LDB(B1, 1, 1); PG8_STAGE(PG8_SB(1, 0), b3, voffB);
            PG8_BAR; PG8_WAIT_L(0); PG8_MMA(0, 1, At, B1); PG8_BAR;
            PG8_LDA(At, 1, 1); PG8_STAGE(PG8_SA(1, 0), a3, voffA);
            PG8_BAR; PG8_WAIT_L(0); PG8_MMA(1, 0, At, B0); PG8_BAR; PG8_SCHED;
            PG8_STAGE(PG8_SB(1, 1), b3 + hstepB, voffB);
            PG8_WAIT_V(6); PG8_BAR; PG8_MMA(1, 1, At, B1); PG8_BAR;
            }
        }
        if constexpr (ALIGN_EPI) { if (wr == 0) PG8_BAR; }
        if constexpr (!Epi::AFTER_DRAIN) { const int l2_ = lane_id_v(); E(acc, cur, wr, wc, l2_ & 15, l2_ >> 4); S.done(cur); }
        if (!has_next) break;
#pragma unroll
        for (int a = 0; a < 2; ++a)
#pragma unroll
            for (int b = 0; b < 2; ++b)
#pragma unroll
                for (int m = 0; m < 4; ++m)
#pragma unroll
                    for (int n = 0; n < 2; ++n) acc[a][b][m][n] = (f32x4){0.f, 0.f, 0.f, 0.f};
        cur = nxt; cA = nA; cB = nB; ++ui;
        if constexpr (ALIGN_EPI) { if (wr == 1) PG8_BAR; }
    }
    PG8_WAIT_V(0);
    if constexpr (!ALIGN_EPI) { if (wr == 0) PG8_BAR; }
    PG8_BAR;
    if constexpr (Epi::AFTER_DRAIN) { E.fused(acc, cur, wr, wc, fr, fq, lds, wid, lane); S.done(cur); }
#undef PG8_SA
#undef PG8_SB
#undef PG8_STAGE
#undef PG8_LDA
#undef PG8_LDB
#undef PG8_MMA
#undef PG8_WAIT_V
#undef PG8_WAIT_L
#undef PG8_BAR
#undef PG8_SCHED
}
}
struct TDesc { int in_idx, in_off, g_idx, g_off; size_t ws_off; int K, ldw, N, row_off, mode, item0; };
constexpr int NTD = 28;
constexpr int TD_ITEMS = 23904;
constexpr int TD_P0 = 2048, TD_R0 = (TD_ITEMS + TD_P0) / 2;
__device__ const TDesc g_td[NTD] = {
    {10, 0, 7, 0, WS_WIN + (size_t)0 * 2, 1024, 1024, 1024, 0, 0, 0},
    {11, 0, 7, 0, WS_WIN + (size_t)0 * 2, 1024, 1024, 1024, 1024, 0, 512},
    {12, 0, 7, 0, WS_WIN + (size_t)0 * 2, 1024, 1024, 1024, 2048, 0, 1024},
    {13, 0, 7, 0, WS_WIN + (size_t)0 * 2, 1024, 1024, 1024, 3072, 0, 1536},
    {15, 0, 14, 0, WS_WHO + (size_t)0 * 2, 1024, 1024, 1024, 0, 0, 2048},
    {27, 0, 8, 0, WS_WUP + (size_t)0 * 2, 1024, 4096, 4096, 0, 0, 2560},
    {28, 0, -1, 0, WS_WDN + (size_t)0 * 2, 4096, 1024, 1024, 0, 0, 4608},
    {10, 1048576, 7, 1024, WS_WIN + (size_t)4194304 * 2, 1024, 1024, 1024, 0, 0, 6656},
    {11, 1048576, 7, 1024, WS_WIN + (size_t)4194304 * 2, 1024, 1024, 1024, 1024, 0, 7168},
    {12, 1048576, 7, 1024, WS_WIN + (size_t)4194304 * 2, 1024, 1024, 1024, 2048, 0, 7680},
    {13, 1048576, 7, 1024, WS_WIN + (size_t)4194304 * 2, 1024, 1024, 1024, 3072, 0, 8192},
    {15, 1048576, 14, 1024, WS_WHO + (size_t)1048576 * 2, 1024, 1024, 1024, 0, 0, 8704},
    {27, 4194304, 8, 1024, WS_WUP + (size_t)4194304 * 2, 1024, 4096, 4096, 0, 0, 9216},
    {28, 4194304, -1, 0, WS_WDN + (size_t)4194304 * 2, 4096, 1024, 1024, 0, 0, 11264},
    {18, 0, 17, 0, WS_WKVQ + (size_t)0 * 2, 1024, 256, 256, 0, 0, 13312},
    {20, 0, 17, 0, WS_WKVQ + (size_t)0 * 2, 1024, 64, 64, 256, 1, 13440},
    {23, 0, 7, 2048, WS_WKVQ + (size_t)0 * 2, 1024, 384, 384, 320, 0, 13472},
    {21, 0, 19, 0, WS_WUKV + (size_t)0 * 2, 256, 1024, 1024, 0, 0, 13664},
    {22, 0, 19, 0, WS_WUKV + (size_t)0 * 2, 256, 1024, 1024, 1024, 0, 13792},
    {25, 0, 24, 0, WS_WUQ + (size_t)0 * 2, 384, 1536, 1536, 0, 2, 13920},
    {26, 0, -1, 0, WS_WO + (size_t)0 * 2, 1024, 1024, 1024, 0, 0, 14208},
    {27, 8388608, 8, 2048, WS_WUP + (size_t)8388608 * 2, 1024, 4096, 4096, 0, 0, 14720},
    {28, 8388608, -1, 0, WS_WDN + (size_t)8388608 * 2, 4096, 1024, 1024, 0, 0, 16768},
    {23, 393216, 7, 3072, WS_WDQ1 + (size_t)0 * 2, 1024, 384, 384, 0, 0, 18816},
    {25, 589824, 24, 384, WS_WUQ + (size_t)589824 * 2, 384, 1536, 1536, 0, 2, 19008},
    {26, 1048576, -1, 0, WS_WO + (size_t)1048576 * 2, 1024, 1024, 1024, 0, 0, 19296},
    {27, 12582912, 8, 3072, WS_WUP + (size_t)12582912 * 2, 1024, 4096, 4096, 0, 0, 19808},
    {28, 12582912, -1, 0, WS_WDN + (size_t)12582912 * 2, 4096, 1024, 1024, 0, 0, 21856},
};
struct Args { const float* in[29]; float* out; unsigned char* ws; int ph_lo, ph_hi, flags, pad; };
struct Frame {
    LAS unsigned char* lds; int wave, G, bid;
    unsigned char* ws; float* out;
};
#define GAS __attribute__((address_space(1)))
template <class TT> __device__ __forceinline__ TT* wsp(unsigned char* ws, size_t off) { return (TT*)(ws + off); }
__device__ __forceinline__ float wave_sum(float v) { return xg_sum(row_sum16(v)); }
__device__ __forceinline__ int td_dest(int mode, int row_off, int n) {
    if (mode == 0) return row_off + n;
    if (mode == 1) return row_off + (n < 32 ? 2 * n : 2 * (n - 32) + 1);
    const int h = n / 192, d = n - h * 192;
    if (d < 128) return h * 128 + d;
    const int i = d - 128; return 1024 + h * 64 + (i < 32 ? 2 * i : 2 * (i - 32) + 1);
}
__device__ __forceinline__ void transpose_item(const float* __restrict__ W, const float* __restrict__ gain, bf16* WT, int K, int ldw, int N, int row_off, int mode, int item, LAS float* scr, int lane) {
    const int nblk = N / 32, kb = item / nblk, nb = item - kb * nblk, k0 = 64 * kb, n0 = 32 * nb;
#pragma unroll 8
    for (int i = 0; i < 32; ++i) { const int kk = 2 * i + (lane >> 5); float w = W[(size_t)(k0 + kk) * ldw + n0 + (lane & 31)]; if (gain) w *= gain[k0 + kk]; scr[kk * 33 + (lane & 31)] = w; }
    LDS_WAIT(); asm volatile("" ::: "memory");
    const int c = lane & 7;
#pragma unroll
    for (int j = 0; j < 4; ++j) { const int n = (lane >> 3) + 8 * j; const LAS float* s = scr + (8 * c) * 33 + n;
        v4u o; o.x = pk2(s[0 * 33], s[1 * 33]); o.y = pk2(s[2 * 33], s[3 * 33]); o.z = pk2(s[4 * 33], s[5 * 33]); o.w = pk2(s[6 * 33], s[7 * 33]);
        *(v4u*)(WT + (size_t)td_dest(mode, row_off, n0 + n) * K + k0 + 8 * c) = o; }
    LDS_WAIT(); asm volatile("" ::: "memory");
}
__device__ __forceinline__ const float* x_row(const Args& A, int r) { return r < MAIN ? A.in[0] + (size_t)r * D : (r - SIDE < NMETA ? A.in[6] + (size_t)(r - SIDE) * D : A.in[1] + (size_t)(r - SIDE - NMETA) * D); }
__device__ __forceinline__ void convert_weights(const Frame& F, const Args& A, int lo, int hi, int gw, int ngw, LAS float* scr, int lane) {
    for (int it = lo + gw; it < hi; it += ngw) {
        int id = 0;
#pragma unroll 1
        for (int k = 1; k < NTD; ++k) if (it >= g_td[k].item0) id = k;
        const TDesc d = g_td[id];
        const float* W = A.in[d.in_idx] + d.in_off; const float* gain = d.g_idx >= 0 ? A.in[d.g_idx] + d.g_off : nullptr;
        transpose_item(W, gain, (bf16*)(F.ws + d.ws_off), d.K, d.ldw, d.N, d.row_off, d.mode, it - d.item0, scr, lane);
    }
}
__device__ __forceinline__ void p0_prologue(const Frame& F, const Args& A) {
    int tid_ = F.wave * 64 + lane_id_v(); const int lane = tid_ & 63, wave = __builtin_amdgcn_readfirstlane(tid_ >> 6);
    LAS float* scr = (LAS float*)(F.lds + wave * 16384);
    const int gw = F.bid * 8 + wave, NGW = F.G * 8;
    convert_weights(F, A, 0, TD_P0, gw, NGW, scr, lane);
    const size_t gt = (size_t)F.bid * 512 + tid_, NGT = (size_t)F.G * 512;
    { v4u z = {0u, 0u, 0u, 0u};
      v4u* p0 = (v4u*)(F.ws + WS_WKVQ + (size_t)704 * 1024 * 2); for (size_t i = gt; i < (size_t)64 * 1024 * 2 / 16; i += NGT) p0[i] = z;
      v4u* p1 = (v4u*)(F.ws + WS_WDQ1 + (size_t)384 * 1024 * 2); for (size_t i = gt; i < (size_t)128 * 1024 * 2 / 16; i += NGT) p1[i] = z;
      v4u* p2 = (v4u*)(F.ws + WS_SSP + (size_t)MAIN * 64); for (size_t i = gt; i < (size_t)(NSS - 1) * MAIN * 64 / 16; i += NGT) p2[i] = z;
      v4u* p2s = (v4u*)(F.ws + WS_SSPS + (size_t)256 * 256); for (size_t i = gt; i < (size_t)(NSS - 1) * 256 * 256 / 16; i += NGT) p2s[i] = z;
      v4u* p3 = (v4u*)(F.ws + WS_OB + (size_t)(SIDE + NSIDE) * D * 2); for (size_t i = gt; i < (size_t)(256 - NSIDE) * D * 2 / 16; i += NGT) p3[i] = z;
      v4u* p4 = (v4u*)(F.ws + WS_AO + (size_t)(SIDE + NSIDE) * D * 2); for (size_t i = gt; i < (size_t)(256 - NSIDE) * D * 2 / 16; i += NGT) p4[i] = z; }
    { bf16* HB = wsp<bf16>(F.ws, WS_HB); float* ss0m = wsp<float>(F.ws, WS_SSP); float* ss0s = wsp<float>(F.ws, WS_SSPS);
      for (int r0 = gw; r0 < M; r0 += 4 * NGW) {
        f32x4 v[4][4];
#pragma unroll
        for (int i = 0; i < 4; ++i) { const int r = r0 + i * NGW; const float* src = nullptr;
            if (r < MAIN) src = A.in[0] + (size_t)r * D; else if (r - SIDE < NMETA) src = A.in[6] + (size_t)(r - SIDE) * D; else if (r - SIDE < NSIDE) src = A.in[1] + (size_t)(r - SIDE - NMETA) * D;
#pragma unroll
            for (int j = 0; j < 4; ++j) { v[i][j] = (f32x4){0.f, 0.f, 0.f, 0.f}; if (src) v[i][j] = *(const f32x4*)(src + 256 * j + 4 * lane); } }
#pragma unroll
        for (int i = 0; i < 4; ++i) { const int r = r0 + i * NGW; float s = 0.f;
            if (r < M) {
#pragma unroll
                for (int j = 0; j < 4; ++j) { const f32x4 x = v[i][j]; v2u w; w.x = pk2(x[0], x[1]); w.y = pk2(x[2], x[3]); *(v2u*)(HB + (size_t)r * D + 256 * j + 4 * lane) = w;
                    s += (x[0] * x[0] + x[1] * x[1]) + (x[2] * x[2] + x[3] * x[3]); }
                s = wave_sum(s); if (r < SIDE) { if (lane < 16) ss0m[(size_t)r * 16 + lane] = lane == 0 ? s : 0.f; } else ss0s[(size_t)(r - SIDE) * 64 + lane] = lane == 0 ? s : 0.f; } }
      } }
    { float* rope = wsp<float>(F.ws, WS_ROPE);
      for (size_t i = gt; i < (size_t)ROPE_SLOTS * 32; i += NGT) { const int slot = (int)(i >> 5), k = (int)(i & 31); const float pos = slot < LPROMPT ? (float)slot : (float)PAST;
        const float invf = (float)exp2(-(double)k * (13.287712379549449 / 32.0));
        const float ang = pos * invf; const double a = (double)ang; const double n = rint(a * 0.6366197723675814); const double r = fma(-n, 1.5707963267948966, a) - n * 6.123233995736766e-17;
        const float rf = (float)r; float sn = __sinf(rf), cs = __cosf(rf); const int q = ((int)n) & 3;
        float c2 = (q == 0) ? cs : (q == 1) ? -sn : (q == 2) ? -cs : sn; float s2 = (q == 0) ? sn : (q == 1) ? cs : (q == 2) ? -sn : -cs;
        rope[2 * i] = c2; rope[2 * i + 1] = s2; }
      float* lbt = wsp<float>(F.ws, WS_LBT); const float* lbw = A.in[16];
      for (size_t i = gt; i < 1024; i += NGT) { const float x0 = lbw[i], x1 = lbw[1024 + i]; const float lb1 = 1.f / (1.f + expf(x0 - x1));
        lbt[i] = 0.f; lbt[1024 + i] = logf(1e-30f); lbt[2048 + i] = 1.f;
        lbt[3072 + i] = log1pf(-lb1); lbt[3072 + 1024 + i] = logf(fmaxf(lb1, 1e-30f)); lbt[3072 + 2048 + i] = 1.f - lb1; } }
}
namespace epi {
using pg8::Unit;
typedef const f32x4 (&AccRef)[2][2][4][2];
__device__ __forceinline__ void st_bf4(bf16* p, f32x4 v) { v2u w; w.x = pk2(v[0], v[1]); w.y = pk2(v[2], v[3]); *(v2u*)p = w; }
__device__ __forceinline__ void st_bf8(bf16* p, f32x4 a, f32x4 b) { v4u w; w.x = pk2(a[0], a[1]); w.y = pk2(a[2], a[3]); w.z = pk2(b[0], b[1]); w.w = pk2(b[2], b[3]); *(v4u*)p = w; }
__device__ __forceinline__ unsigned dpp_ror8u(unsigned x) { return (unsigned)__builtin_amdgcn_update_dpp(0, (int)x, 0x128, 0xf, 0xf, false); }
__device__ __forceinline__ void st_lines(bf16* p, size_t stride, v4u W0, v4u W1, int fr) {
    const bool lo = fr < 8; v4u send, recv;
    send.x = lo ? W1.x : W0.x; send.y = lo ? W1.y : W0.y; send.z = lo ? W1.z : W0.z; send.w = lo ? W1.w : W0.w;
    recv.x = dpp_ror8u(send.x); recv.y = dpp_ror8u(send.y); recv.z = dpp_ror8u(send.z); recv.w = dpp_ror8u(send.w);
    v4u first, second;
    first.x = lo ? W0.x : recv.x; first.y = lo ? W0.y : recv.y; first.z = lo ? W0.z : recv.z; first.w = lo ? W0.w : recv.w;
    second.x = lo ? recv.x : W1.x; second.y = lo ? recv.y : W1.y; second.z = lo ? recv.z : W1.z; second.w = lo ? recv.w : W1.w;
    bf16* p0 = lo ? p : p - 8 * stride + 8; bf16* p1 = lo ? p + 8 * stride : p + 8;
    *(v4u*)p0 = first; *(v4u*)p1 = second;
}
__device__ __forceinline__ v4u pk8(f32x4 a, f32x4 b) { v4u w; w.x = pk2(a[0], a[1]); w.y = pk2(a[2], a[3]); w.z = pk2(b[0], b[1]); w.w = pk2(b[2], b[3]); return w; }
__device__ __forceinline__ float silu(float x) { return x * __builtin_amdgcn_rcpf(1.f + __expf(-x)); }
__device__ __forceinline__ float sumsq(f32x4 v) { return (v[0] * v[0] + v[1] * v[1]) + (v[2] * v[2] + v[3] * v[3]); }
__device__ __forceinline__ void row_ss_put(const SSW s, int row, float q, int fq, int slot) {
    q = xg_sum(q);
    if (fq == 0) { if (row < SIDE) s.m[(size_t)row * 16 + slot] = q; else s.s[(size_t)(row - SIDE) * 64 + slot] = q; }
}
__device__ __forceinline__ f32x4 rope4(const float* rope, int row, int i, f32x4 x) {
    const f32x4 cs = *(const f32x4*)(rope + ((size_t)pos_slot(row) * 32 + i) * 2);
    f32x4 y; y[0] = x[0] * cs[0] - x[1] * cs[1]; y[1] = x[1] * cs[0] + x[0] * cs[1]; y[2] = x[2] * cs[2] - x[3] * cs[3]; y[3] = x[3] * cs[2] + x[2] * cs[3]; return y;
}
template <class E> struct Big {
    static constexpr bool PERM = true, AFTER_DRAIN = false; E e;
    __device__ __forceinline__ void operator()(AccRef acc, const Unit& u, int wr, int wc, int fr, int fq) const {
        const int cb = u.pn * 256, c16 = cb + wc * 64 + fq * 16;
#pragma unroll
        for (int ai = 0; ai < 2; ++ai) {
            float rs[4]; f32x4 pre[4][2][2];
#pragma unroll
            for (int m = 0; m < 4; ++m) { const int row = u.pm * 256 + ai * 128 + wr * 64 + m * 16 + fr; rs[m] = e.row_begin(row);
#pragma unroll
                for (int bj = 0; bj < 2; ++bj) e.load8(row, c16 + 8 * bj, pre[m][bj][0], pre[m][bj][1]); }
#pragma unroll
            for (int m = 0; m < 4; ++m) { const int row = u.pm * 256 + ai * 128 + wr * 64 + m * 16 + fr; float q = 0.f;
                if constexpr (E::LINES) q = e.apply16(row, c16, cb, acc[ai][0][m][0], acc[ai][0][m][1], acc[ai][1][m][0], acc[ai][1][m][1], rs[m], pre[m][0][0], pre[m][0][1], pre[m][1][0], pre[m][1][1], fr);
                else {
#pragma unroll
                    for (int bj = 0; bj < 2; ++bj) q += e.apply8(row, c16 + 8 * bj, cb, acc[ai][bj][m][0], acc[ai][bj][m][1], rs[m], pre[m][bj][0], pre[m][bj][1]); }
                e.row_end(row, q, fq, cb, u.pn * 4 + wc); }
            asm volatile("" ::: "memory");
        }
    }
};
struct HgIn {
    static constexpr bool LINES = true;
    SSR ss; bf16 *QB, *KB, *VB, *GB; float* LF; const float* lbt;
    __device__ __forceinline__ float row_begin(int row) const { return rstd_of(ss_get(ss, row), 1.f / D); }
    __device__ __forceinline__ f32x4 load(int, int) const { return (f32x4){0.f, 0.f, 0.f, 0.f}; }
    __device__ __forceinline__ float apply(int row, int col, int cb, f32x4 a, float rs, f32x4) const {
        const int kind = cb >> 10, c = col & (D - 1); const size_t o = (size_t)row * D + c; const f32x4 x = a * rs;
        if (kind == 0) { f32x4 y; y[0] = silu(x[0]); y[1] = silu(x[1]); y[2] = silu(x[2]); y[3] = silu(x[3]); st_bf4(QB + o, y); }
        else if (kind == 1) {
            const f32x4 L1 = *(const f32x4*)(lbt + c), L2 = *(const f32x4*)(lbt + D + c), OM = *(const f32x4*)(lbt + 2 * D + c);
            f32x4 lf, kk;
#pragma unroll
            for (int e = 0; e < 4; ++e) { const float z = x[e];
                const float ez = __expf(-fabsf(z)), r1 = __builtin_amdgcn_rcpf(1.f + ez);
                const float ls = fminf(z, 0.f) - __logf(1.f + ez);
                const float aa = L1[e] + ls, cc = L2[e], dd = fabsf(aa - cc);
                lf[e] = fmaxf(aa, cc) + (dd < 24.f ? __logf(1.f + __expf(-dd)) : 0.f);
                kk[e] = OM[e] * (z > 0.f ? ez : 1.f) * r1; }
            *(f32x4*)(LF + o) = lf; st_bf4(KB + o, kk); }
        else if (kind == 2) st_bf4(VB + o, x);
        else { f32x4 y; y[0] = silu(x[0]); y[1] = silu(x[1]); y[2] = silu(x[2]); y[3] = silu(x[3]); st_bf4(GB + o, y); }
        return 0.f;
    }
    __device__ __forceinline__ void load8(int, int, f32x4& p0, f32x4& p1) const { p0 = (f32x4){0.f, 0.f, 0.f, 0.f}; p1 = p0; }
    __device__ __forceinline__ float apply8(int row, int col, int cb, f32x4 a0, f32x4 a1, float rs, f32x4 p0, f32x4 p1) const {
        const int kind = cb >> 10, c = col & (D - 1); const size_t o = (size_t)row * D + c;
        if (kind == 1) { apply(row, col, cb, a0, rs, p0); apply(row, col + 4, cb, a1, rs, p1); return 0.f; }
        f32x4 x0 = a0 * rs, x1 = a1 * rs;
        if (kind != 2) {
#pragma unroll
            for (int e = 0; e < 4; ++e) { x0[e] = silu(x0[e]); x1[e] = silu(x1[e]); } }
        if (kind == 0) st_bf8(QB + o, x0, x1); else if (kind == 2) st_bf8(VB + o, x0, x1); else st_bf8(GB + o, x0, x1);
        return 0.f; }
    __device__ __forceinline__ float apply16(int row, int col, int cb, f32x4 a0, f32x4 a1, f32x4 a2, f32x4 a3, float rs, f32x4 p0, f32x4 p1, f32x4 p2, f32x4 p3, int fr) const {
        const int kind = cb >> 10, c = col & (D - 1); const size_t o = (size_t)row * D + c;
        if (kind == 1) { apply(row, col, cb, a0, rs, p0); apply(row, col + 4, cb, a1, rs, p1); apply(row, col + 8, cb, a2, rs, p2); apply(row, col + 12, cb, a3, rs, p3); return 0.f; }
        f32x4 x0 = a0 * rs, x1 = a1 * rs, x2 = a2 * rs, x3 = a3 * rs;
        if (kind != 2) {
#pragma unroll
            for (int e = 0; e < 4; ++e) { x0[e] = silu(x0[e]); x1[e] = silu(x1[e]); x2[e] = silu(x2[e]); x3[e] = silu(x3[e]); } }
        const v4u W0 = pk8(x0, x1), W1 = pk8(x2, x3);
        if (kind == 0) st_lines(QB + o, D, W0, W1, fr); else if (kind == 2) st_lines(VB + o, D, W0, W1, fr); else st_lines(GB + o, D, W0, W1, fr);
        return 0.f; }
    __device__ __forceinline__ void row_end(int, float, int, int, int) const {}
};
template <bool FIRST> struct ResT {
    static constexpr bool LINES = true;
    const float* Xin; bf16* HB; SSW ssn; int dry; const float* meta; const float* xs;
    __device__ __forceinline__ float row_begin(int) const { return 1.f; }
    __device__ __forceinline__ f32x4 load(int row, int col) const {
        if constexpr (FIRST) { const float* src = Xin + (size_t)row * D + col;
            if (row >= SIDE) src = (row - SIDE < NMETA ? meta + (size_t)(row - SIDE) * D : xs + (size_t)(row - SIDE - NMETA) * D) + col;
            return *(const f32x4*)src; }
        else { const v2u w = *(const v2u*)(HB + (size_t)row * D + col); return (f32x4){bflo(w.x), bfhi(w.x), bflo(w.y), bfhi(w.y)}; } }
    __device__ __forceinline__ float apply(int row, int col, int, f32x4 a, float, f32x4 pre) const { const size_t o = (size_t)row * D + col;
        const f32x4 h = pre + a; if (!dry) st_bf4(HB + o, h); return sumsq(h); }
    __device__ __forceinline__ void load8(int row, int col, f32x4& p0, f32x4& p1) const {
        if constexpr (FIRST) { p0 = load(row, col); p1 = load(row, col + 4); }
        else { const v4u w = *(const v4u*)(HB + (size_t)row * D + col); p0 = (f32x4){bflo(w.x), bfhi(w.x), bflo(w.y), bfhi(w.y)}; p1 = (f32x4){bflo(w.z), bfhi(w.z), bflo(w.w), bfhi(w.w)}; } }
    __device__ __forceinline__ float apply8(int row, int col, int, f32x4 a0, f32x4 a1, float, f32x4 p0, f32x4 p1) const { const f32x4 h0 = p0 + a0, h1 = p1 + a1;
        if (!dry) st_bf8(HB + (size_t)row * D + col, h0, h1); return sumsq(h0) + sumsq(h1); }
    __device__ __forceinline__ float apply16(int row, int col, int, f32x4 a0, f32x4 a1, f32x4 a2, f32x4 a3, float, f32x4 p0, f32x4 p1, f32x4 p2, f32x4 p3, int fr) const {
        const f32x4 h0 = p0 + a0, h1 = p1 + a1, h2 = p2 + a2, h3 = p3 + a3;
        if (!dry) st_lines(HB + (size_t)row * D + col, D, pk8(h0, h1), pk8(h2, h3), fr);
        return (sumsq(h0) + sumsq(h1)) + (sumsq(h2) + sumsq(h3)); }
    __device__ __forceinline__ void row_end(int row, float q, int fq, int, int slot) const { if (!dry) row_ss_put(ssn, row, q, fq, slot); }
};
struct Up {
    static constexpr bool LINES = true;
    SSR ss; bf16* HID;
    __device__ __forceinline__ float row_begin(int row) const { return rstd_of(ss_get(ss, row), 1.f / D); }
    __device__ __forceinline__ f32x4 load(int, int) const { return (f32x4){0.f, 0.f, 0.f, 0.f}; }
    __device__ __forceinline__ float apply(int row, int col, int, f32x4 a, float rs, f32x4) const { f32x4 x = a * rs;
#pragma unroll
        for (int e = 0; e < 4; ++e) { const float r = fmaxf(x[e], 0.f); x[e] = r * r; }
        st_bf4(HID + (size_t)row * FF + col, x); return 0.f; }
    __device__ __forceinline__ void load8(int, int, f32x4& p0, f32x4& p1) const { p0 = (f32x4){0.f, 0.f, 0.f, 0.f}; p1 = p0; }
    __device__ __forceinline__ float apply8(int row, int col, int, f32x4 a0, f32x4 a1, float rs, f32x4, f32x4) const { f32x4 x0 = a0 * rs, x1 = a1 * rs;
#pragma unroll
        for (int e = 0; e < 4; ++e) { const float r0 = fmaxf(x0[e], 0.f), r1 = fmaxf(x1[e], 0.f); x0[e] = r0 * r0; x1[e] = r1 * r1; }
        st_bf8(HID + (size_t)row * FF + col, x0, x1); return 0.f; }
    __device__ __forceinline__ float apply16(int row, int col, int, f32x4 a0, f32x4 a1, f32x4 a2, f32x4 a3, float rs, f32x4, f32x4, f32x4, f32x4, int fr) const {
        f32x4 x0 = a0 * rs, x1 = a1 * rs, x2 = a2 * rs, x3 = a3 * rs;
#pragma unroll
        for (int e = 0; e < 4; ++e) { const float r0 = fmaxf(x0[e], 0.f), r1 = fmaxf(x1[e], 0.f), r2 = fmaxf(x2[e], 0.f), r3 = fmaxf(x3[e], 0.f); x0[e] = r0 * r0; x1[e] = r1 * r1; x2[e] = r2 * r2; x3[e] = r3 * r3; }
        st_lines(HID + (size_t)row * FF + col, FF, pk8(x0, x1), pk8(x2, x3), fr); return 0.f; }
    __device__ __forceinline__ void row_end(int, float, int, int, int) const {}
};
struct KvQ {
    static constexpr bool LINES = false;
    SSR ss; float* CKVF; bf16* CKVB; float* KRF; bf16* KRB; bf16* CQB; SSW ss_ckv; SSW ss_cq; const float* rope;
    __device__ __forceinline__ float row_begin(int row) const { return rstd_of(ss_get(ss, row), 1.f / D); }
    __device__ __forceinline__ f32x4 load(int, int) const { return (f32x4){0.f, 0.f, 0.f, 0.f}; }
    __device__ __forceinline__ float apply(int row, int col, int, f32x4 a, float rs, f32x4) const {
        const f32x4 x = a * rs;
        if (col < KVL) { *(f32x4*)(CKVF + (size_t)row * KVL + col) = x; st_bf4(CKVB + (size_t)row * KVL + col, x); return sumsq(x); }
        if (col < KVL + ROPE) { const int jj = col - KVL, i = jj >> 1; const f32x4 y = rope4(rope, row, i, x);
            float* kf = KRF + (size_t)row * ROPE; kf[i] = y[0]; kf[32 + i] = y[1]; kf[i + 1] = y[2]; kf[33 + i] = y[3];
            st_bf4(KRB + (size_t)row * ROPE + jj, y); return 0.f; }
        if (col < KVL + ROPE + QL) { st_bf4(CQB + (size_t)row * QL + (col - KVL - ROPE), x); return sumsq(x); }
        return 0.f;
    }
    __device__ __forceinline__ void load8(int, int, f32x4& p0, f32x4& p1) const { p0 = (f32x4){0.f, 0.f, 0.f, 0.f}; p1 = p0; }
    __device__ __forceinline__ float apply8(int row, int col, int cb, f32x4 a0, f32x4 a1, float rs, f32x4 p0, f32x4 p1) const {
        if (col >= KVL + ROPE && col < KVL + ROPE + QL) { const f32x4 x0 = a0 * rs, x1 = a1 * rs; st_bf8(CQB + (size_t)row * QL + (col - KVL - ROPE), x0, x1); return sumsq(x0) + sumsq(x1); }
        return apply(row, col, cb, a0, rs, p0) + apply(row, col + 4, cb, a1, rs, p1); }
    __device__ __forceinline__ void row_end(int row, float q, int fq, int cb, int slot) const { if (cb < KVL) row_ss_put(ss_ckv, row, q, fq, row < SIDE ? (slot & 3) : slot); else row_ss_put(ss_cq, row, q, fq, row < SIDE ? slot - 4 : slot); }
};
struct Dq {
    static constexpr bool LINES = false;
    SSR ss; bf16* CQB; SSW ss_cq;
    __device__ __forceinline__ float row_begin(int row) const { return rstd_of(ss_get(ss, row), 1.f / D); }
    __device__ __forceinline__ f32x4 load(int, int) const { return (f32x4){0.f, 0.f, 0.f, 0.f}; }
    __device__ __forceinline__ float apply(int row, int col, int, f32x4 a, float rs, f32x4) const { const f32x4 x = a * rs; if (col < QL) { st_bf4(CQB + (size_t)row * QL + col, x); return sumsq(x); } return 0.f; }
    __device__ __forceinline__ void load8(int, int, f32x4& p0, f32x4& p1) const { p0 = (f32x4){0.f, 0.f, 0.f, 0.f}; p1 = p0; }
    __device__ __forceinline__ float apply8(int row, int col, int, f32x4 a0, f32x4 a1, float rs, f32x4, f32x4) const { const f32x4 x0 = a0 * rs, x1 = a1 * rs; if (col < QL) { st_bf8(CQB + (size_t)row * QL + col, x0, x1); return sumsq(x0) + sumsq(x1); } return 0.f; }
    __device__ __forceinline__ void row_end(int row, float q, int fq, int, int slot) const { row_ss_put(ss_cq, row, q, fq, slot); }
};
struct Uq {
    static constexpr bool LINES = false;
    SSR ss_cq; bf16* QN; bf16* QR; const float* rope;
    __device__ __forceinline__ float row_begin(int row) const { return rstd_of(ss_get(ss_cq, row), 1.f / QL); }
    __device__ __forceinline__ f32x4 load(int, int) const { return (f32x4){0.f, 0.f, 0.f, 0.f}; }
    __device__ __forceinline__ float apply(int row, int col, int cb, f32x4 a, float rs, f32x4) const {
        const f32x4 x = a * rs;
        if (cb < D) st_bf4(QN + (size_t)row * D + col, x);
        else { const int cc = col - D; st_bf4(QR + (size_t)row * 512 + cc, rope4(rope, row, (cc & 63) >> 1, x)); }
        return 0.f;
    }
    __device__ __forceinline__ void load8(int, int, f32x4& p0, f32x4& p1) const { p0 = (f32x4){0.f, 0.f, 0.f, 0.f}; p1 = p0; }
    __device__ __forceinline__ float apply8(int row, int col, int cb, f32x4 a0, f32x4 a1, float rs, f32x4, f32x4) const {
        const f32x4 x0 = a0 * rs, x1 = a1 * rs;
        if (cb < D) st_bf8(QN + (size_t)row * D + col, x0, x1);
        else { const int cc = col - D; st_bf8(QR + (size_t)row * 512 + cc, rope4(rope, row, (cc & 63) >> 1, x0), rope4(rope, row, ((cc + 4) & 63) >> 1, x1)); }
        return 0.f; }
    __device__ __forceinline__ void row_end(int, float, int, int, int) const {}
};
struct KvUp {
    static constexpr bool LINES = false;
    SSR ss_ckv; bf16* KN; bf16* VV;
    __device__ __forceinline__ float row_begin(int row) const { return rstd_of(ss_get(ss_ckv, row), 1.f / KVL); }
    __device__ __forceinline__ f32x4 load(int, int) const { return (f32x4){0.f, 0.f, 0.f, 0.f}; }
    __device__ __forceinline__ float apply(int row, int col, int cb, f32x4 a, float rs, f32x4) const { const f32x4 x = a * rs; if (cb < D) st_bf4(KN + (size_t)row * D + col, x); else st_bf4(VV + (size_t)row * D + (col - D), x); return 0.f; }
    __device__ __forceinline__ void load8(int, int, f32x4& p0, f32x4& p1) const { p0 = (f32x4){0.f, 0.f, 0.f, 0.f}; p1 = p0; }
    __device__ __forceinline__ float apply8(int row, int col, int cb, f32x4 a0, f32x4 a1, float rs, f32x4, f32x4) const { const f32x4 x0 = a0 * rs, x1 = a1 * rs; if (cb < D) st_bf8(KN + (size_t)row * D + col, x0, x1); else st_bf8(VV + (size_t)row * D + (col - D), x0, x1); return 0.f; }
    __device__ __forceinline__ void row_end(int, float, int, int, int) const {}
};

constexpr int SIDE_MT = NSIDE / 16;
template <class E> __device__ __forceinline__ void side_gemm(const Frame& F, const bf16* __restrict__ A, const bf16* __restrict__ Bt, int N, int K, const E& e) {
    const int tid = F.wave * 64 + lane_id_v(), w = __builtin_amdgcn_readfirstlane(tid >> 6), lane = tid & 63, g = lane >> 4, li = lane & 15;
    LAS f32x4* red = (LAS f32x4*)F.lds;
    const int nks = K / 32, ncg = N / 16;
    int nrp = (F.G * 16) / N; nrp = nrp < 1 ? 1 : (nrp > SIDE_MT ? SIDE_MT : nrp);
    for (int it = F.bid; it < ncg * nrp; it += F.G) {
        const int cg = it / nrp, rp = it - cg * nrp, m0 = (rp * SIDE_MT) / nrp, m1 = ((rp + 1) * SIDE_MT) / nrp;
        f32x4 acc[SIDE_MT];
#pragma unroll
        for (int mt = 0; mt < SIDE_MT; ++mt) acc[mt] = (f32x4){0.f, 0.f, 0.f, 0.f};
        const bf16* bp = Bt + (size_t)(cg * 16 + li) * K + 8 * g; const bf16* ap = A + (size_t)(SIDE + li) * K + 8 * g;
#pragma unroll 4
        for (int ks = w; ks < nks; ks += 8) {
            const bf16x8 bfr = *(const bf16x8*)(bp + 32 * ks); bf16x8 afr[SIDE_MT];
#pragma unroll
            for (int mt = 0; mt < SIDE_MT; ++mt) if (mt >= m0 && mt < m1) afr[mt] = *(const bf16x8*)(ap + (size_t)(16 * mt) * K + 32 * ks);
#pragma unroll
            for (int mt = 0; mt < SIDE_MT; ++mt) if (mt >= m0 && mt < m1) acc[mt] = mfma16(bfr, afr[mt], acc[mt]);
        }
#pragma unroll
        for (int mt = 0; mt < SIDE_MT; ++mt) if (mt >= m0 && mt < m1) red[(w * SIDE_MT + mt) * 64 + lane] = acc[mt];
        __syncthreads();
#pragma unroll 1
        for (int mt = m0 + w; mt < m1; mt += 8) {
            f32x4 s = red[mt * 64 + lane];
#pragma unroll
            for (int ww = 1; ww < 8; ++ww) s += red[(ww * SIDE_MT + mt) * 64 + lane];
            const int row = SIDE + 16 * mt + li, cb = cg * 16; const float rs = e.row_begin(row);
            const float q = e.apply(row, cb + 4 * g, cb, s, rs, e.load(row, cb + 4 * g)); e.row_end(row, q, g, cb, cg);
        }
        __syncthreads();
    }
}
}
constexpr int HG_RS = 288;
constexpr int HG_QT = 0, HG_KT = 32 * HG_RS, HG_VT = 2 * 32 * HG_RS, HG_GT = 3 * 32 * HG_RS, HG_OT = 4 * 32 * HG_RS, HG_EC = 5 * 32 * HG_RS, HG_WTOT = HG_EC + 512, HG_SSX = HG_WTOT + 8 * 128 * 4, HG_END = HG_SSX + 32 * 8 * 4;
#define HG_BAR() do { asm volatile("s_waitcnt lgkmcnt(0)" ::: "memory"); __builtin_amdgcn_s_barrier(); asm volatile("" ::: "memory"); } while (0)
struct HgRegs { v4u q, k, v, gt; f32x4 l0, l1; };
struct HgCtx { const bf16 *QB, *KB, *VB, *GB; const float* LF; bf16* OB; LAS unsigned char* lds; int tid, w, lane, g, li, st, skg, b, h; };
__device__ __forceinline__ int hg_row(const HgCtx& C, int c, int t) { return c == 0 ? SIDE + t : C.b * T + 32 * (c - 1) + t; }
__device__ __forceinline__ bool hg_live(const HgCtx& C, int c, int t) { return c > 0 ? true : (t < NMETA); }
__device__ __forceinline__ void hg_load(const HgCtx& C, HgRegs& R, int c) {
    const int tk = C.lane & 31; const size_t o = (size_t)hg_row(C, c, tk) * D + C.h * HK + 16 * C.w + 8 * (C.lane >> 5);
    R.q = (v4u){0u, 0u, 0u, 0u}; R.k = R.q; R.v = R.q; R.gt = R.q; R.l0 = (f32x4){0.f, 0.f, 0.f, 0.f}; R.l1 = R.l0;
    if (hg_live(C, c, tk)) { R.q = *(const v4u*)(C.QB + o); R.k = *(const v4u*)(C.KB + o); R.v = *(const v4u*)(C.VB + o); R.gt = *(const v4u*)(C.GB + o); R.l0 = *(const f32x4*)(C.LF + o); R.l1 = *(const f32x4*)(C.LF + o + 4); }
}
template <int CTRL, int RMASK> __device__ __forceinline__ float dpp_mv(float x) { return __builtin_bit_cast(float, __builtin_amdgcn_update_dpp(0, __builtin_bit_cast(int, x), CTRL, RMASK, 0xf, false)); }
__device__ __forceinline__ float scan32(float x) {
    x += dpp_mv<0x111, 0xf>(x); x += dpp_mv<0x112, 0xf>(x); x += dpp_mv<0x114, 0xf>(x); x += dpp_mv<0x118, 0xf>(x);
    x += dpp_mv<0x142, 0xa>(x); return x;
}
__device__ __forceinline__ void hg_store_out(const HgCtx& C, int c) {
    if (hg_live(C, c, C.st) && (c > 0 || C.b == 0)) *(v4u*)(C.OB + (size_t)hg_row(C, c, C.st) * D + C.h * HV + 8 * C.skg) = *(const LAS v4u*)(C.lds + HG_OT + C.st * HG_RS + C.skg * 16);
}
__device__ __forceinline__ void hg_chunk(const HgCtx& C, HgRegs& R, f32x4 (&S)[8], int c, int nch) {
    LAS unsigned char* Qt = C.lds + HG_QT; LAS unsigned char* Kt = C.lds + HG_KT; LAS unsigned char* Vt = C.lds + HG_VT; LAS unsigned char* Gt = C.lds + HG_GT; LAS unsigned char* Ot = C.lds + HG_OT;
    LAS float* eC = (LAS float*)(C.lds + HG_EC); LAS float* ssx = (LAS float*)(C.lds + HG_SSX);
    const int w = C.w, lane = C.lane, g = C.g, li = C.li;
    float x[8] = {R.l0[0], R.l0[1], R.l0[2], R.l0[3], R.l1[0], R.l1[1], R.l1[2], R.l1[3]};
#pragma unroll
    for (int e = 0; e < 8; ++e) x[e] = scan32(x[e]);
    HG_BAR();
    if (c > 0) hg_store_out(C, c - 1);
    { const int tk = lane & 31, cb = 16 * w + 8 * (lane >> 5);
      const unsigned qw[4] = {R.q.x, R.q.y, R.q.z, R.q.w}, kw[4] = {R.k.x, R.k.y, R.k.z, R.k.w}; unsigned oq[4], ok[4];
#pragma unroll
      for (int e = 0; e < 4; ++e) { const float e0 = __expf(x[2 * e]), e1 = __expf(x[2 * e + 1]), i0 = __expf(fminf(-x[2 * e], 80.f)), i1 = __expf(fminf(-x[2 * e + 1], 80.f));
          oq[e] = pk2(bflo(qw[e]) * e0, bfhi(qw[e]) * e1); ok[e] = pk2(bflo(kw[e]) * i0, bfhi(kw[e]) * i1);
          if (tk == 31) { eC[cb + 2 * e] = e0; eC[cb + 2 * e + 1] = e1; } }
      *(LAS v4u*)(Qt + tk * HG_RS + cb * 2) = (v4u){oq[0], oq[1], oq[2], oq[3]}; *(LAS v4u*)(Kt + tk * HG_RS + cb * 2) = (v4u){ok[0], ok[1], ok[2], ok[3]};
      *(LAS v4u*)(Vt + tk * HG_RS + cb * 2) = R.v; *(LAS v4u*)(Gt + tk * HG_RS + cb * 2) = R.gt; }
    HG_BAR();
    if (c + 2 < nch) hg_load(C, R, c + 2);
    const unsigned kr_ = (unsigned)(size_t)(Kt + li * HG_RS + 16 * g), qr_ = (unsigned)(size_t)(Qt + li * HG_RS + 16 * g), qa_ = (unsigned)(size_t)(Qt + li * HG_RS + 8 * g);
    const unsigned vp_ = (unsigned)(size_t)(Vt + (4 * g + (li >> 2)) * HG_RS + (16 * w + 4 * (li & 3)) * 2), kp_ = (unsigned)(size_t)(Kt + (4 * g + (li >> 2)) * HG_RS + (4 * (li & 3)) * 2);
    const unsigned ec_ = (unsigned)(size_t)((LAS unsigned char*)eC + 16 * g);
    bf16x8 k0[4], k1[4], q0[4], q1[4]; s16x4 vlo, vhi, al[4][2], ah[4][2], klo[8], khi[8]; f32x4 ecv[8];
#pragma unroll
    for (int ks = 0; ks < 4; ++ks) {
        asm volatile("ds_read_b128 %0, %1 offset:%2" : "=v"(k0[ks]) : "v"(kr_), "i"(64 * ks));
        asm volatile("ds_read_b128 %0, %1 offset:%2" : "=v"(k1[ks]) : "v"(kr_), "i"(16 * HG_RS + 64 * ks));
        asm volatile("ds_read_b128 %0, %1 offset:%2" : "=v"(q0[ks]) : "v"(qr_), "i"(64 * ks));
        asm volatile("ds_read_b128 %0, %1 offset:%2" : "=v"(q1[ks]) : "v"(qr_), "i"(16 * HG_RS + 64 * ks)); }
    asm volatile("ds_read_b64_tr_b16 %0, %1 offset:%2" : "=v"(vlo) : "v"(vp_), "i"(0));
    asm volatile("ds_read_b64_tr_b16 %0, %1 offset:%2" : "=v"(vhi) : "v"(vp_), "i"(16 * HG_RS));
#pragma unroll
    for (int ks = 0; ks < 4; ++ks) {
        asm volatile("ds_read_b64 %0, %1 offset:%2" : "=v"(al[ks][0]) : "v"(qa_), "i"(64 * ks));
        asm volatile("ds_read_b64 %0, %1 offset:%2" : "=v"(al[ks][1]) : "v"(qa_), "i"(64 * ks + 32));
        asm volatile("ds_read_b64 %0, %1 offset:%2" : "=v"(ah[ks][0]) : "v"(qa_), "i"(16 * HG_RS + 64 * ks));
        asm volatile("ds_read_b64 %0, %1 offset:%2" : "=v"(ah[ks][1]) : "v"(qa_), "i"(16 * HG_RS + 64 * ks + 32)); }
    asm volatile("s_waitcnt lgkmcnt(15)" : "+v"(k0[0]), "+v"(k0[1]), "+v"(k0[2]), "+v"(k0[3]), "+v"(k1[0]), "+v"(k1[1]), "+v"(k1[2]), "+v"(k1[3]), "+v"(q0[0]), "+v"(q0[1]), "+v"(q0[2]), "+v"(q0[3]), "+v"(q1[0]), "+v"(q1[1]), "+v"(q1[2]), "+v"(q1[3]), "+v"(vlo), "+v"(vhi));
    f32x4 d00 = {0.f, 0.f, 0.f, 0.f}, d01 = d00, d11 = d00;
#pragma unroll
    for (int ks = 0; ks < 4; ++ks) { d00 = mfma16(k0[ks], q0[ks], d00); d01 = mfma16(k0[ks], q1[ks], d01); d11 = mfma16(k1[ks], q1[ks], d11); }
#pragma unroll
    for (int r = 0; r < 4; ++r) { if (4 * g + r > li) { d00[r] = 0.f; d11[r] = 0.f; } }
    const bf16x8 p0 = pack8(d00, (f32x4){0.f, 0.f, 0.f, 0.f}), p1 = pack8(d01, d11);
    const bf16x8 vf = cat4(vlo, vhi);
    f32x4 o0 = mfma16(p0, vf, (f32x4){0.f, 0.f, 0.f, 0.f}), o1 = mfma16(p1, vf, (f32x4){0.f, 0.f, 0.f, 0.f});
    asm volatile("s_waitcnt lgkmcnt(0)" : "+v"(al[0][0]), "+v"(al[0][1]), "+v"(al[1][0]), "+v"(al[1][1]), "+v"(al[2][0]), "+v"(al[2][1]), "+v"(al[3][0]), "+v"(al[3][1]), "+v"(ah[0][0]), "+v"(ah[0][1]), "+v"(ah[1][0]), "+v"(ah[1][1]), "+v"(ah[2][0]), "+v"(ah[2][1]), "+v"(ah[3][0]), "+v"(ah[3][1]));
#define HG_RD3(kb_) do { asm volatile("ds_read_b64_tr_b16 %0, %1 offset:%2" : "=v"(klo[kb_]) : "v"(kp_), "i"(32 * (kb_))); \
        asm volatile("ds_read_b64_tr_b16 %0, %1 offset:%2" : "=v"(khi[kb_]) : "v"(kp_), "i"(16 * HG_RS + 32 * (kb_))); \
        asm volatile("ds_read_b128 %0, %1 offset:%2" : "=v"(ecv[kb_]) : "v"(ec_), "i"(64 * (kb_))); } while (0)
    HG_RD3(0); HG_RD3(1); HG_RD3(2); HG_RD3(3);
#pragma unroll
    for (int ks = 0; ks < 4; ++ks) {
        const bf16x8 sb = pack8(S[2 * ks], S[2 * ks + 1]);
        o0 = mfma16(cat4(al[ks][0], al[ks][1]), sb, o0); o1 = mfma16(cat4(ah[ks][0], ah[ks][1]), sb, o1);
    }
    HG_RD3(4); HG_RD3(5); HG_RD3(6); HG_RD3(7);
#undef HG_RD3
    asm volatile("s_waitcnt lgkmcnt(12)" : "+v"(klo[0]), "+v"(klo[1]), "+v"(klo[2]), "+v"(klo[3]), "+v"(khi[0]), "+v"(khi[1]), "+v"(khi[2]), "+v"(khi[3]), "+v"(ecv[0]), "+v"(ecv[1]), "+v"(ecv[2]), "+v"(ecv[3]));
#pragma unroll
    for (int kb = 0; kb < 4; ++kb) S[kb] = mfma16(cat4(klo[kb], khi[kb]), vf, S[kb]) * ecv[kb];
    asm volatile("s_waitcnt lgkmcnt(0)" : "+v"(klo[4]), "+v"(klo[5]), "+v"(klo[6]), "+v"(klo[7]), "+v"(khi[4]), "+v"(khi[5]), "+v"(khi[6]), "+v"(khi[7]), "+v"(ecv[4]), "+v"(ecv[5]), "+v"(ecv[6]), "+v"(ecv[7]));
#pragma unroll
    for (int kb = 4; kb < 8; ++kb) S[kb] = mfma16(cat4(klo[kb], khi[kb]), vf, S[kb]) * ecv[kb];
    float q2[8];
#pragma unroll
    for (int r = 0; r < 4; ++r) { q2[r] = o0[r] * o0[r]; q2[4 + r] = o1[r] * o1[r]; }
#pragma unroll
    for (int e = 0; e < 8; ++e) q2[e] = row_sum16(q2[e]);
    if (li == 0) {
#pragma unroll
        for (int r = 0; r < 4; ++r) { ssx[(4 * g + r) * 8 + w] = q2[r]; ssx[(16 + 4 * g + r) * 8 + w] = q2[4 + r]; } }
    HG_BAR();
#pragma unroll
    for (int tb = 0; tb < 2; ++tb)
#pragma unroll
        for (int r = 0; r < 4; ++r) { const int t = 16 * tb + 4 * g + r; const f32x4 s0 = *(const LAS f32x4*)(ssx + t * 8), s1 = *(const LAS f32x4*)(ssx + t * 8 + 4);
            const float rs = rstd_of((s0[0] + s0[1]) + (s0[2] + s0[3]) + (s1[0] + s1[1]) + (s1[2] + s1[3]), 1.f / HV);
            const float gv = bf2f(*(const LAS bf16*)(Gt + t * HG_RS + (16 * w + li) * 2));
            *(LAS bf16*)(Ot + t * HG_RS + (16 * w + li) * 2) = (bf16)f2bf((tb == 0 ? o0[r] : o1[r]) * rs * gv); }
}
__device__ __forceinline__ void hg_prompt_unit(const Frame& F, int l, int u) {
    HgCtx C; C.tid = F.wave * 64 + lane_id_v(); C.w = __builtin_amdgcn_readfirstlane(C.tid >> 6); C.lane = C.tid & 63; C.g = C.lane >> 4; C.li = C.lane & 15; C.st = C.tid >> 4; C.skg = C.tid & 15;
    C.b = u >> 3; C.h = u & 7; C.lds = F.lds;
    C.QB = wsp<bf16>(F.ws, WS_QB); C.KB = wsp<bf16>(F.ws, WS_KB); C.VB = wsp<bf16>(F.ws, WS_VB); C.GB = wsp<bf16>(F.ws, WS_GB); C.LF = wsp<float>(F.ws, WS_LF); C.OB = wsp<bf16>(F.ws, WS_OB);
    f32x4 S[8];
#pragma unroll
    for (int kb = 0; kb < 8; ++kb) S[kb] = (f32x4){0.f, 0.f, 0.f, 0.f};
    constexpr int NCH = 1 + T / 32;
    HgRegs RA, RB; hg_load(C, RA, 0); hg_load(C, RB, 1);
#pragma unroll 1
    for (int c = 0; c < NCH; c += 2) { hg_chunk(C, RA, S, c, NCH); if (c + 1 < NCH) hg_chunk(C, RB, S, c + 1, NCH); }
    HG_BAR();
    hg_store_out(C, NCH - 1);
    float* so = F.out + O_SP + ((size_t)(l * NB + C.b) * HH + C.h) * HK * HV;
#pragma unroll
    for (int kb = 0; kb < 8; ++kb)
#pragma unroll
        for (int r = 0; r < 4; ++r) so[(size_t)(16 * kb + 4 * C.g + r) * HV + 16 * C.w + C.li] = S[kb][r];
    __syncthreads();
}
__device__ __forceinline__ void hg_sample_unit(const Frame& F, const float* state_in, int l, int u) {
    int tid_ = F.wave * 64 + lane_id_v(); const int tid = tid_, w = __builtin_amdgcn_readfirstlane(tid >> 6), lane = tid & 63, hw = lane >> 5, l32 = lane & 31;
    const int bs = u >> 3, h = u & 7; const int row = SIDE + NMETA + bs;
    const bf16* QB = wsp<bf16>(F.ws, WS_QB); const bf16* KB = wsp<bf16>(F.ws, WS_KB); const bf16* VB = wsp<bf16>(F.ws, WS_VB); const bf16* GB = wsp<bf16>(F.ws, WS_GB);
    const float* LF = wsp<float>(F.ws, WS_LF); bf16* OB = wsp<bf16>(F.ws, WS_OB);
    LAS float* part = (LAS float*)F.lds;
    const size_t so = ((size_t)(l * NS + bs) * HH + h) * HK * HV; const float* s0 = state_in + so; float* s1 = F.out + O_SS + so;
    const size_t ro = (size_t)row * D + h * HK;
    const v2u vv = *(const v2u*)(VB + ro + 4 * l32); const f32x4 v4 = {bflo(vv.x), bfhi(vv.x), bflo(vv.y), bfhi(vv.y)};
    f32x4 st[8]; float fv[8], kv[8], qv[8];
#pragma unroll
    for (int i = 0; i < 8; ++i) { const int k = 16 * w + 2 * i + hw; st[i] = *(const f32x4*)(s0 + (size_t)k * HV + 4 * l32); fv[i] = LF[ro + k]; kv[i] = bf2f(KB[ro + k]); qv[i] = bf2f(QB[ro + k]); }
    f32x4 o = {0.f, 0.f, 0.f, 0.f};
#pragma unroll
    for (int i = 0; i < 8; ++i) { const int k = 16 * w + 2 * i + hw; const f32x4 a = st[i] * __expf(fv[i]) + v4 * kv[i]; *(f32x4*)(s1 + (size_t)k * HV + 4 * l32) = a; o += a * qv[i]; }
#pragma unroll
    for (int e = 0; e < 4; ++e) o[e] = half_sum(o[e]);
    if (hw == 0) *(LAS f32x4*)(part + w * 128 + 4 * l32) = o;
    HG_BAR();
    float s = 0.f;
    if (tid < 128) {
#pragma unroll
        for (int ww = 0; ww < 8; ++ww) s += part[ww * 128 + tid];
        const float q = wave_sum(s * s); if (lane == 0) part[1024 + w] = q; }
    HG_BAR();
    if (tid < 128) { const float rs = rstd_of(part[1024] + part[1025], 1.f / HV); OB[ro + tid] = (bf16)f2bf(s * rs * bf2f(GB[ro + tid])); }
    HG_BAR();
}
__device__ __forceinline__ void kv_outputs(const Frame& F, const float* kv_gain) {
    const float* CKVF = wsp<float>(F.ws, WS_CKVF); const float* KRF = wsp<float>(F.ws, WS_KRF); const SSR ssc{wsp<float>(F.ws, WS_SSP) + (size_t)SS_CKV * MAIN * 16, wsp<float>(F.ws, WS_SSPS) + (size_t)SS_CKV * 256 * 64};
    int tid_ = F.wave * 64 + lane_id_v(); const int lane = tid_ & 63, gw = F.bid * 8 + __builtin_amdgcn_readfirstlane(tid_ >> 6), NGW = F.G * 8; const f32x4 g4 = *(const f32x4*)(kv_gain + 4 * lane);
    for (int i = gw; i < NB * LPROMPT + NS; i += NGW) {
        int src; float* oc; float* ok;
        if (i < NB * LPROMPT) { const int b = i / LPROMPT, p = i - b * LPROMPT; src = p < NMETA ? SIDE + p : b * T + p - NMETA; oc = F.out + O_CKVP + (size_t)i * KVL; ok = F.out + O_KRP + (size_t)i * ROPE; }
        else { const int bs = i - NB * LPROMPT; src = SIDE + NMETA + bs; oc = F.out + O_CKVS + (size_t)bs * KVL; ok = F.out + O_KRS + (size_t)bs * ROPE; }
        const float rs = rstd_of(ss_get(ssc, src), 1.f / KVL); const f32x4 x = *(const f32x4*)(CKVF + (size_t)src * KVL + 4 * lane);
        *(f32x4*)(oc + 4 * lane) = x * rs * g4; ok[lane] = KRF[(size_t)src * ROPE + lane];
    }
}
__device__ __forceinline__ void final_norm(const Frame& F, const float* gain) {
    const bf16* HB = wsp<bf16>(F.ws, WS_HB); const SSR ss{wsp<float>(F.ws, WS_SSP) + (size_t)8 * MAIN * 16, wsp<float>(F.ws, WS_SSPS) + (size_t)8 * 256 * 64};
    int tid_ = F.wave * 64 + lane_id_v(); const int lane = tid_ & 63, gw = F.bid * 8 + __builtin_amdgcn_readfirstlane(tid_ >> 6), NGW = F.G * 8;
    for (int i = gw; i < MAIN + NS; i += NGW) {
        const int r = i < MAIN ? i : SIDE + NMETA + (i - MAIN); float* o = i < MAIN ? F.out + O_Y + (size_t)i * D : F.out + O_YS + (size_t)(i - MAIN) * D;
        const float rs = rstd_of(ss_get(ss, r), 1.f / D);
#pragma unroll
        for (int j = 0; j < 4; ++j) { const int c = 256 * j + 4 * lane; const v2u w = *(const v2u*)(HB + (size_t)r * D + c);
            *(f32x4*)(o + c) = (f32x4){bflo(w.x), bfhi(w.x), bflo(w.y), bfhi(w.y)} * rs * *(const f32x4*)(gain + c); }
    }
}
constexpr int P_KS = 400, P_VS = 288, P_VOFF = 64 * P_KS, P_BUF = P_VOFF + 64 * P_VS;
#define ATT_BAR() do { asm volatile("s_waitcnt lgkmcnt(0)" ::: "memory"); __builtin_amdgcn_s_barrier(); asm volatile("" ::: "memory"); } while (0)
struct AttnUnit { int b, h, qb, meta; };
__device__ __forceinline__ void prefill_tile(LAS unsigned char* Kt, LAS unsigned char* Vt, const bf16x8 (&qf)[2][6], f32x4 (&o)[2][8], float (&mrun)[2], float (&lrun)[2], int t, int tq0, int li, int g, const AttnUnit U) {
        const int k0 = 64 * (t - 1);
        if (t == 0 || k0 <= tq0 + 31) {
            f32x4 st[2][4];
#pragma unroll
            for (int nq = 0; nq < 2; ++nq)
#pragma unroll
                for (int kb = 0; kb < 4; ++kb) st[nq][kb] = (f32x4){0.f, 0.f, 0.f, 0.f};
            { const unsigned ka_ = (unsigned)(size_t)(Kt + li * P_KS + 16 * g); bf16x8 kA[3], kB[3];
#define P_RD3(K_, kb_, hf_) do { _Pragma("unroll") for (int s = 0; s < 3; ++s) asm volatile("ds_read_b128 %0, %1 offset:%2" : "=v"(K_[s]) : "v"(ka_), "i"((kb_) * 16 * P_KS + 64 * (3 * (hf_) + s))); } while (0)
#define P_WT3(K_, n_) asm volatile("s_waitcnt lgkmcnt(" #n_ ")" : "+v"(K_[0]), "+v"(K_[1]), "+v"(K_[2]))
#define P_MM3(K_, kb_, hf_) do { _Pragma("unroll") for (int s = 0; s < 3; ++s) { st[0][kb_] = mfma16(K_[s], qf[0][3 * (hf_) + s], st[0][kb_]); st[1][kb_] = mfma16(K_[s], qf[1][3 * (hf_) + s], st[1][kb_]); } } while (0)
              P_RD3(kA, 0, 0);
              P_RD3(kB, 0, 1); P_WT3(kA, 3); P_MM3(kA, 0, 0);
              P_RD3(kA, 1, 0); P_WT3(kB, 3); P_MM3(kB, 0, 1);
              P_RD3(kB, 1, 1); P_WT3(kA, 3); P_MM3(kA, 1, 0);
              P_RD3(kA, 2, 0); P_WT3(kB, 3); P_MM3(kB, 1, 1);
              P_RD3(kB, 2, 1); P_WT3(kA, 3); P_MM3(kA, 2, 0);
              P_RD3(kA, 3, 0); P_WT3(kB, 3); P_MM3(kB, 2, 1);
              P_RD3(kB, 3, 1); P_WT3(kA, 3); P_MM3(kA, 3, 0);
              P_WT3(kB, 0); P_MM3(kB, 3, 1);
#undef P_RD3
#undef P_WT3
#undef P_MM3
            }
            bf16x8 pf[2][2];
#pragma unroll
            for (int nq = 0; nq < 2; ++nq) {
                const int tq = tq0 + 16 * nq + li;
                if (t == 0) {
#pragma unroll
                    for (int kb = 0; kb < 4; ++kb)
#pragma unroll
                        for (int r = 0; r < 4; ++r) { const int key = 16 * kb + 4 * g + r; if (key >= NMETA || (U.meta && key > li)) st[nq][kb][r] = NEG; }
                } else if (k0 + 63 > tq0) {
#pragma unroll
                    for (int kb = 0; kb < 4; ++kb)
#pragma unroll
                        for (int r = 0; r < 4; ++r) { const int key = k0 + 16 * kb + 4 * g + r; if (key > tq) st[nq][kb][r] = NEG; }
                }
                float mx = fmaxf(fmaxf(max4(st[nq][0]), max4(st[nq][1])), fmaxf(max4(st[nq][2]), max4(st[nq][3])));
                mx = xg_max(mx);
                if (__builtin_amdgcn_ballot_w64(mx > mrun[nq]) != 0ull) {
                    const float mnew = fmaxf(mrun[nq], mx), alpha = __builtin_amdgcn_exp2f((mrun[nq] - mnew) * ATT_C); mrun[nq] = mnew; lrun[nq] *= alpha;
#pragma unroll
                    for (int vb = 0; vb < 8; ++vb) o[nq][vb] = o[nq][vb] * alpha;
                }
                const float mc = -mrun[nq] * ATT_C; float rs = 0.f;
#pragma unroll
                for (int kb = 0; kb < 4; ++kb)
#pragma unroll
                    for (int r = 0; r < 4; ++r) { const float p = __builtin_amdgcn_exp2f(fmaf(st[nq][kb][r], ATT_C, mc)); st[nq][kb][r] = p; rs += p; }
                lrun[nq] += xg_sum(rs);
                pf[nq][0] = pack8(st[nq][0], st[nq][1]); pf[nq][1] = pack8(st[nq][2], st[nq][3]);
            }
            { const unsigned va_ = (unsigned)(size_t)(Vt + (4 * g + (li >> 2)) * P_VS + (4 * (li & 3)) * 2); s16x4 vA[4], vB[4];
#define P_RD4(V_, k32_, q_) do { _Pragma("unroll") for (int i = 0; i < 2; ++i) { \
                  asm volatile("ds_read_b64_tr_b16 %0, %1 offset:%2" : "=v"(V_[2 * i]) : "v"(va_), "i"((32 * (k32_)) * P_VS + 32 * (2 * (q_) + i))); \
                  asm volatile("ds_read_b64_tr_b16 %0, %1 offset:%2" : "=v"(V_[2 * i + 1]) : "v"(va_), "i"((32 * (k32_) + 16) * P_VS + 32 * (2 * (q_) + i))); } } while (0)
#define P_WT4(V_, n_) asm volatile("s_waitcnt lgkmcnt(" #n_ ")" : "+v"(V_[0]), "+v"(V_[1]), "+v"(V_[2]), "+v"(V_[3]))
#define P_MM4(V_, k32_, q_) do { _Pragma("unroll") for (int i = 0; i < 2; ++i) { const bf16x8 a = cat4(V_[2 * i], V_[2 * i + 1]); \
                  o[0][2 * (q_) + i] = mfma16(a, pf[0][k32_], o[0][2 * (q_) + i]); o[1][2 * (q_) + i] = mfma16(a, pf[1][k32_], o[1][2 * (q_) + i]); } } while (0)
              P_RD4(vA, 0, 0);
              P_RD4(vB, 0, 1); P_WT4(vA, 4); P_MM4(vA, 0, 0);
              P_RD4(vA, 0, 2); P_WT4(vB, 4); P_MM4(vB, 0, 1);
              P_RD4(vB, 0, 3); P_WT4(vA, 4); P_MM4(vA, 0, 2);
              P_RD4(vA, 1, 0); P_WT4(vB, 4); P_MM4(vB, 0, 3);
              P_RD4(vB, 1, 1); P_WT4(vA, 4); P_MM4(vA, 1, 0);
              P_RD4(vA, 1, 2); P_WT4(vB, 4); P_MM4(vB, 1, 1);
              P_RD4(vB, 1, 3); P_WT4(vA, 4); P_MM4(vA, 1, 2);
              P_WT4(vB, 0); P_MM4(vB, 1, 3);
#undef P_RD4
#undef P_WT4
#undef P_MM4
            }
        }
}
__device__ __forceinline__ void attn_prefill_unit(const Frame& F, const AttnUnit U) {
    const bf16* QN = wsp<bf16>(F.ws, WS_QN); const bf16* QR = wsp<bf16>(F.ws, WS_QR); const bf16* KN = wsp<bf16>(F.ws, WS_KN); const bf16* VV = wsp<bf16>(F.ws, WS_VV);
    const bf16* KRB = wsp<bf16>(F.ws, WS_KRB); bf16* AO = wsp<bf16>(F.ws, WS_AO);
    int tid_ = F.wave * 64 + lane_id_v(); const int tid = tid_, w = __builtin_amdgcn_readfirstlane(tid >> 6), lane = tid & 63, g = lane >> 4, li = lane & 15, h = U.h;
    const int tq0 = U.qb * 256 + 32 * w;
    const int rowq0 = U.meta ? SIDE + 32 * w : U.b * T + tq0;
    const int ntiles = U.meta ? 1 : 1 + 4 * (U.qb + 1);
    bf16x8 qf[2][6];
#pragma unroll
    for (int nq = 0; nq < 2; ++nq) { const size_t row = (size_t)(rowq0 + 16 * nq + li);
#pragma unroll
        for (int s = 0; s < 6; ++s) qf[nq][s] = s < 4 ? *(const bf16x8*)(QN + row * D + h * NOPE + 32 * s + 8 * g) : *(const bf16x8*)(QR + row * 512 + h * ROPE + 32 * (s - 4) + 8 * g); }
    f32x4 o[2][8]; float mrun[2], lrun[2];
#pragma unroll
    for (int nq = 0; nq < 2; ++nq) { mrun[nq] = NEG; lrun[nq] = 0.f;
#pragma unroll
        for (int vb = 0; vb < 8; ++vb) o[nq][vb] = (f32x4){0.f, 0.f, 0.f, 0.f}; }
    v4u kreg[3], vreg[2];
#define P_LOAD_TILE(t_) do { const int keyrow0_ = (t_) == 0 ? SIDE : U.b * T + 64 * ((t_) - 1); \
        _Pragma("unroll") for (int j = 0; j < 3; ++j) { const int c = tid + 512 * j, key = c / 24, ch = c - key * 24; const size_t kr = (size_t)(keyrow0_ + key); \
            kreg[j] = ch < 16 ? *(const v4u*)(KN + kr * D + h * NOPE + 8 * ch) : *(const v4u*)(KRB + kr * ROPE + 8 * (ch - 16)); } \
        _Pragma("unroll") for (int j = 0; j < 2; ++j) { const int c = tid + 512 * j, key = c >> 4, ch = c & 15; vreg[j] = *(const v4u*)(VV + (size_t)(keyrow0_ + key) * D + h * VD + 8 * ch); } } while (0)
#define P_STORE_TILE(buf_) do { LAS unsigned char* kt_ = F.lds + (buf_) * P_BUF; LAS unsigned char* vt_ = kt_ + P_VOFF; \
        _Pragma("unroll") for (int j = 0; j < 3; ++j) { const int c = tid + 512 * j, key = c / 24, ch = c - key * 24; *(LAS v4u*)(kt_ + key * P_KS + ch * 16) = kreg[j]; } \
        _Pragma("unroll") for (int j = 0; j < 2; ++j) { const int c = tid + 512 * j, key = c >> 4, ch = c & 15; *(LAS v4u*)(vt_ + key * P_VS + ch * 16) = vreg[j]; } } while (0)
    P_LOAD_TILE(0); P_STORE_TILE(0); ATT_BAR();
#pragma unroll 1
    for (int t = 0; t < ntiles; ++t) {
        LAS unsigned char* Kt = F.lds + (t & 1) * P_BUF;
        if (t + 1 < ntiles) P_LOAD_TILE(t + 1);
        prefill_tile(Kt, Kt + P_VOFF, qf, o, mrun, lrun, t, tq0, li, g, U);
        if (t + 1 < ntiles) P_STORE_TILE((t + 1) & 1);
        ATT_BAR();
    }
#undef P_LOAD_TILE
#undef P_STORE_TILE
#pragma unroll
    for (int nq = 0; nq < 2; ++nq) {
        if (!U.meta || (w == 0 && nq == 0)) { const float inv = 1.f / lrun[nq]; const size_t row = (size_t)(rowq0 + 16 * nq + li);
#pragma unroll
            for (int vb = 0; vb < 8; ++vb) { const f32x4 v = o[nq][vb] * inv; v2u wv; wv.x = pk2(v[0], v[1]); wv.y = pk2(v[2], v[3]); *(v2u*)(AO + row * D + h * VD + 16 * vb + 4 * g) = wv; } }
    }
    __syncthreads();
}

constexpr int D_KS = 672, D_KT = 64 * D_KS, D_QOFF = 2 * D_KT;
struct DRegs { f32x4 c[8], r[2]; };
constexpr int NSPLIT = 2, PART_STRIDE = 2112;
__device__ __forceinline__ void attn_decode_unit(const Frame& F, const Args& A, int bs, int sp) {
    const bf16* QN = wsp<bf16>(F.ws, WS_QN); const bf16* QR = wsp<bf16>(F.ws, WS_QR);
    const float* CKVF = wsp<float>(F.ws, WS_CKVF); const float* KRF = wsp<float>(F.ws, WS_KRF); const SSR ssc{wsp<float>(F.ws, WS_SSP) + (size_t)SS_CKV * MAIN * 16, wsp<float>(F.ws, WS_SSPS) + (size_t)SS_CKV * 256 * 64};
    const char* cache_ckv = (const char*)A.in[3]; const char* cache_kr = (const char*)A.in[4]; const float* w_uk = A.in[21]; const float* kv_gain = A.in[19];
    const int* ptab = (const int*)A.in[5] + ((AFLAGS & 64) ? 0 : bs * NPG);
    int tid_ = F.wave * 64 + lane_id_v(); const int tid = tid_, w = __builtin_amdgcn_readfirstlane(tid >> 6), lane = tid & 63, g = lane >> 4, li = lane & 15, kg = w & 3, vh = w >> 2; const int srow = SIDE + NMETA + bs;
    LAS unsigned char* qbuf = F.lds + D_QOFF;
#pragma unroll 1
    for (int j = 0; j < 4; ++j) { const int idx = tid + 512 * j, hh = idx >> 8, r = idx & 255; const bf16* qp = QN + (size_t)srow * D + hh * NOPE; const float* wp = w_uk + ((size_t)r * HH + hh) * NOPE; float s = 0.f;
#pragma unroll 8
        for (int n = 0; n < NOPE; n += 4) { const v2u qv = *(const v2u*)(qp + n); const f32x4 wv = *(const f32x4*)(wp + n); s += bflo(qv.x) * wv[0] + bfhi(qv.x) * wv[1] + bflo(qv.y) * wv[2] + bfhi(qv.y) * wv[3]; }
        *(LAS bf16*)(qbuf + (hh * 320 + r) * 2) = (bf16)f2bf(s); }
    { const int hh = tid >> 6, jj = tid & 63, i = jj >> 1; *(LAS bf16*)(qbuf + (hh * 320 + 256 + ((jj & 1) ? 32 + i : i)) * 2) = QR[(size_t)srow * 512 + hh * ROPE + jj]; }
    for (int i = tid; i < 8 * 320 / 2; i += 512) *(LAS unsigned*)(qbuf + 8 * 640 + 4 * i) = 0u;
    __syncthreads();
    bf16x8 qf[10];
#pragma unroll
    for (int s = 0; s < 10; ++s) qf[s] = *(const LAS bf16x8*)(qbuf + li * 640 + (32 * s + 8 * g) * 2);
    f32x4 o[8]; float mrun = NEG, lrun = 0.f;
#pragma unroll
    for (int vb = 0; vb < 8; ++vb) o[vb] = (f32x4){0.f, 0.f, 0.f, 0.f};
    const float rs_new = rstd_of(ss_get(ssc, srow), 1.f / KVL);
    constexpr int NT = 2 * NPG + 1; const int t0 = sp * 64 + (sp > 0 ? 1 : 0), t1 = (sp + 1) * 64 + 1;
    const unsigned offc = (unsigned)((tid >> 6) * KVL + 4 * (tid & 63)) * 4u, offr = (unsigned)((tid >> 4) * ROPE + 4 * (tid & 15)) * 4u;
    const unsigned ldc = (unsigned)((tid >> 6) * D_KS + (tid & 63) * 8), ldr = (unsigned)((tid >> 4) * D_KS + 512 + (tid & 15) * 8);
    DRegs RA, RB;
#define D_LOAD(R, t_) do { if ((t_) < 2 * NPG) { const int pg_ = __builtin_amdgcn_readfirstlane(ptab[(t_) >> 1]); const size_t row0_ = (size_t)pg_ * PAGE + ((t_) & 1) * 64; \
            const char* cb_ = cache_ckv + row0_ * (KVL * 4); const char* rb_ = cache_kr + row0_ * (ROPE * 4); \
            _Pragma("unroll") for (int j = 0; j < 8; ++j) R.c[j] = __builtin_nontemporal_load((const f32x4*)(cb_ + (offc + (unsigned)j * 8192u))); \
            _Pragma("unroll") for (int j = 0; j < 2; ++j) R.r[j] = __builtin_nontemporal_load((const f32x4*)(rb_ + (offr + (unsigned)j * 8192u))); \
        } else {   \
            _Pragma("unroll") for (int j = 0; j < 8; ++j) R.c[j] = (f32x4){0.f, 0.f, 0.f, 0.f}; \
            _Pragma("unroll") for (int j = 0; j < 2; ++j) R.r[j] = (f32x4){0.f, 0.f, 0.f, 0.f}; \
            if (tid < 64) R.c[0] = *(const f32x4*)(CKVF + (size_t)srow * KVL + 4 * tid) * rs_new * *(const f32x4*)(kv_gain + 4 * tid); \
            if (tid < 16) R.r[0] = *(const f32x4*)(KRF + (size_t)srow * ROPE + 4 * tid); } } while (0)
#define D_TILE(R, t_) do { const int tt_ = (t_); LAS unsigned char* Kt = F.lds + (tt_ & 1) * D_KT; \
        _Pragma("unroll") for (int j = 0; j < 8; ++j) { v2u wv; wv.x = pk2(R.c[j][0], R.c[j][1]); wv.y = pk2(R.c[j][2], R.c[j][3]); *(LAS v2u*)(Kt + ldc + j * (8 * D_KS)) = wv; } \
        _Pragma("unroll") for (int j = 0; j < 2; ++j) { v2u wv; wv.x = pk2(R.r[j][0], R.r[j][1]); wv.y = pk2(R.r[j][2], R.r[j][3]); *(LAS v2u*)(Kt + ldr + j * (32 * D_KS)) = wv; } \
        ATT_BAR();                                                           \
        if (tt_ + 2 < t1) D_LOAD(R, tt_ + 2);                                \
        f32x4 st = {0.f, 0.f, 0.f, 0.f}; \
        { const unsigned ka_ = (unsigned)(size_t)(Kt + (16 * kg + li) * D_KS + 16 * g); bf16x8 dA[5], dB[5];     \
          _Pragma("unroll") for (int s = 0; s < 5; ++s) asm volatile("ds_read_b128 %0, %1 offset:%2" : "=v"(dA[s]) : "v"(ka_), "i"(64 * s)); \
          _Pragma("unroll") for (int s = 0; s < 5; ++s) asm volatile("ds_read_b128 %0, %1 offset:%2" : "=v"(dB[s]) : "v"(ka_), "i"(64 * (5 + s))); \
          asm volatile("s_waitcnt lgkmcnt(5)" : "+v"(dA[0]), "+v"(dA[1]), "+v"(dA[2]), "+v"(dA[3]), "+v"(dA[4])); \
          _Pragma("unroll") for (int s = 0; s < 5; ++s) st = mfma16(dA[s], qf[s], st); \
          asm volatile("s_waitcnt lgkmcnt(0)" : "+v"(dB[0]), "+v"(dB[1]), "+v"(dB[2]), "+v"(dB[3]), "+v"(dB[4])); \
          _Pragma("unroll") for (int s = 0; s < 5; ++s) st = mfma16(dB[s], qf[5 + s], st); } \
        if (tt_ == NT - 1) { \
            _Pragma("unroll") for (int r = 0; r < 4; ++r) if (16 * kg + 4 * g + r != 0) st[r] = NEG; } \
        const float mx = xg_max(max4(st)); \
        if (__builtin_amdgcn_ballot_w64(mx > mrun) != 0ull) {                \
            const float mnew = fmaxf(mrun, mx), alpha = __builtin_amdgcn_exp2f((mrun - mnew) * ATT_C); mrun = mnew; lrun *= alpha; \
            _Pragma("unroll") for (int vb = 0; vb < 8; ++vb) o[vb] = o[vb] * alpha; } \
        float rs = 0.f; \
        _Pragma("unroll") for (int r = 0; r < 4; ++r) { const float p = __builtin_amdgcn_exp2f((st[r] - mrun) * ATT_C); st[r] = p; rs += p; } \
        lrun += xg_sum(rs); \
        const bf16x8 pf = pack8(st, (f32x4){0.f, 0.f, 0.f, 0.f}); \
        LAS unsigned char* ap = Kt + (16 * kg + 4 * g + (li >> 2)) * D_KS + (128 * vh + 4 * (li & 3)) * 2; \
        { const unsigned va_ = (unsigned)(size_t)ap; s16x4 tv[8];                \
          _Pragma("unroll") for (int vb = 0; vb < 8; ++vb) asm volatile("ds_read_b64_tr_b16 %0, %1 offset:%2" : "=v"(tv[vb]) : "v"(va_), "i"(32 * vb)); \
          asm volatile("s_waitcnt lgkmcnt(0)" : "+v"(tv[0]), "+v"(tv[1]), "+v"(tv[2]), "+v"(tv[3]), "+v"(tv[4]), "+v"(tv[5]), "+v"(tv[6]), "+v"(tv[7])); \
          _Pragma("unroll") for (int vb = 0; vb < 8; ++vb) o[vb] = mfma16(cat4(tv[vb], tv[vb]), pf, o[vb]); } } while (0)
    D_LOAD(RA, t0); D_LOAD(RB, t0 + 1);
#pragma unroll 1
    for (int t = t0; t < t1; t += 2) { D_TILE(RA, t); if (t + 1 < t1) D_TILE(RB, t + 1); }
#undef D_LOAD
#undef D_TILE
    __syncthreads();
    LAS float* cm = (LAS float*)(F.lds);
    LAS float* ml = cm + 8 * 8 * 64 * 4;
    if (kg != 0) {
#pragma unroll
        for (int vb = 0; vb < 8; ++vb) *(LAS f32x4*)(cm + ((w * 8 + vb) * 64 + lane) * 4) = o[vb];
        ml[(w * 64 + lane) * 2] = mrun; ml[(w * 64 + lane) * 2 + 1] = lrun;
    }
    __syncthreads();
    if (kg == 0) {
        float mm = mrun;
#pragma unroll
        for (int k = 1; k < 4; ++k) mm = fmaxf(mm, ml[((w + k) * 64 + lane) * 2]);
        const float e0 = __builtin_amdgcn_exp2f((mrun - mm) * ATT_C); float L = lrun * e0;
#pragma unroll
        for (int vb = 0; vb < 8; ++vb) o[vb] = o[vb] * e0;
#pragma unroll
        for (int k = 1; k < 4; ++k) { const float ek = __builtin_amdgcn_exp2f((ml[((w + k) * 64 + lane) * 2] - mm) * ATT_C); L += ml[((w + k) * 64 + lane) * 2 + 1] * ek;
#pragma unroll
            for (int vb = 0; vb < 8; ++vb) o[vb] += *(const LAS f32x4*)(cm + (((w + k) * 8 + vb) * 64 + lane) * 4) * ek; }
        float* part = wsp<float>(F.ws, WS_PART) + (size_t)(((AFLAGS & 64) ? NS * NSPLIT : 0) + bs * NSPLIT + sp) * PART_STRIDE;
        if (li < 8) {
#pragma unroll
            for (int vb = 0; vb < 8; ++vb) *(f32x4*)(part + li * 256 + 128 * vh + 16 * vb + 4 * g) = o[vb];
            if (vh == 0 && g == 0) { part[2048 + li] = mm; part[2056 + li] = L; }
        }
    }
    __syncthreads();
}
__device__ __forceinline__ void attn_combine_unit(const Frame& F, const Args& A, int bs) {
    const int tid = F.wave * 64 + lane_id_v(); const int srow = SIDE + NMETA + bs; const float* w_uv = A.in[22]; bf16* AO = wsp<bf16>(F.ws, WS_AO);
    const float* part = wsp<float>(F.ws, WS_PART) + (size_t)bs * NSPLIT * PART_STRIDE; LAS float* olat = (LAS float*)F.lds;
#pragma unroll 1
    for (int j = 0; j < 4; ++j) { const int idx = tid + 512 * j, hh = idx >> 8; float mm = NEG;
#pragma unroll
        for (int s = 0; s < NSPLIT; ++s) mm = fmaxf(mm, part[s * PART_STRIDE + 2048 + hh]);
        float L = 0.f, ov = 0.f;
#pragma unroll
        for (int s = 0; s < NSPLIT; ++s) { const float e = __builtin_amdgcn_exp2f((part[s * PART_STRIDE + 2048 + hh] - mm) * ATT_C); L += part[s * PART_STRIDE + 2056 + hh] * e; ov += part[s * PART_STRIDE + idx] * e; }
        olat[idx] = ov / L; }
    __syncthreads();
#pragma unroll 1
    for (int j = 0; j < 2; ++j) { const int idx = tid + 512 * j, hh = idx >> 7, v = idx & 127; float s = 0.f;
#pragma unroll 8
        for (int r = 0; r < KVL; ++r) s += olat[hh * 256 + r] * w_uv[((size_t)r * HH + hh) * VD + v];
        AO[(size_t)srow * D + hh * VD + v] = (bf16)f2bf(s); }
    __syncthreads();
}
#define SSRD(i_) (SSR{SSPm + (size_t)(i_) * MAIN * 16, SSPs + (size_t)(i_) * 256 * 64})
#define SSWR(i_) (SSW{SSPm + (size_t)(i_) * MAIN * 16, SSPs + (size_t)(i_) * 256 * 64})
constexpr int NPH = 26;
__global__ void __launch_bounds__(512, 2) yoco_fwd(Args A) {
    extern __shared__ __attribute__((aligned(16))) unsigned char lds_raw[];
    Frame F0; F0.lds = (LAS unsigned char*)lds_raw; F0.wave = __builtin_amdgcn_readfirstlane((int)threadIdx.x >> 6);
    F0.G = gridDim.x; F0.bid = blockIdx.x; F0.ws = A.ws; F0.out = A.out;
    volatile LAS unsigned* MISC = (volatile LAS unsigned*)(F0.lds + LDSCTL_OFF);
    if (threadIdx.x < 64) MISC[threadIdx.x] = 0u;
    __syncthreads();
    const bool fused = PROBE_BUILD ? (A.ph_hi - A.ph_lo) > 1 : true;
    XcdBarrier bar; bar.bar = (unsigned*)(A.ws + WS_CTL) + 4096; bar.x = 0; bar.st = MISC + 8;
    if (fused) bar = xcd_barrier_post((unsigned*)(A.ws + WS_CTL) + 4096, MISC + 8);
    int ph = 0; (void)ph;
#ifndef EN_MASK
#define EN_MASK 0xFFFF
#endif
#ifndef REPEAT_MASK
#define REPEAT_MASK 0ull
#endif
#ifndef PROBE_BUILD
#define PROBE_BUILD 0
#endif
#if PROBE_BUILD
#define PHASE_BEGIN(k) if (ph >= A.ph_lo && ph < A.ph_hi) { if constexpr ((EN_MASK >> (k)) & 1) { Frame F = F0; { GAS unsigned char* wg_ = (GAS unsigned char*)F.ws; GAS float* og_ = (GAS float*)F.out; asm volatile("" : "+s"(wg_), "+s"(og_), "+s"(F.G), "+s"(F.bid), "+s"(F.wave)); F.ws = (unsigned char*)wg_; F.out = (float*)og_; }     \
    float* SSPm = wsp<float>(F.ws, WS_SSP); float* SSPs = wsp<float>(F.ws, WS_SSPS); bf16* HB = wsp<bf16>(F.ws, WS_HB); const float* rope = wsp<float>(F.ws, WS_ROPE); (void)SSPm; (void)SSPs; (void)HB; (void)rope;
#define PHASE_END } if (ph + 1 < A.ph_hi) { XcdBarrier b_ = bar; { GAS unsigned* bg_ = (GAS unsigned*)b_.bar; asm volatile("" : "+s"(bg_), "+s"(b_.x)); b_.bar = (unsigned*)bg_; } xcd_barrier(b_); } } ++ph;
#define PHASE_END_LAST } } ++ph;
#else
#define PHASE_BEGIN(k) { { Frame F = F0; { GAS unsigned char* wg_ = (GAS unsigned char*)F.ws; GAS float* og_ = (GAS float*)F.out; asm volatile("" : "+s"(wg_), "+s"(og_), "+s"(F.G), "+s"(F.bid), "+s"(F.wave)); F.ws = (unsigned char*)wg_; F.out = (float*)og_; }     \
    float* SSPm = wsp<float>(F.ws, WS_SSP); float* SSPs = wsp<float>(F.ws, WS_SSPS); bf16* HB = wsp<bf16>(F.ws, WS_HB); const float* rope = wsp<float>(F.ws, WS_ROPE); (void)SSPm; (void)SSPs; (void)HB; (void)rope;
#define PHASE_END } { XcdBarrier b_ = bar; { GAS unsigned* bg_ = (GAS unsigned*)b_.bar; asm volatile("" : "+s"(bg_), "+s"(b_.x)); b_.bar = (unsigned*)bg_; } xcd_barrier(b_); } }
#define PHASE_END_LAST } }
#endif

    PHASE_BEGIN(0) p0_prologue(F, A); PHASE_END

#pragma unroll 1
    for (int l = 0; l < 4; ++l) {
        if (l < 2) {
            PHASE_BEGIN(1)
                pg8::Gemm g{HB, wsp<bf16>(F.ws, WS_WIN) + (size_t)l * 4096 * 1024, MAIN, 4096, D}; pg8::StaticOrder S; S.init(MAIN, 4096, F.G, F.bid);
                epi::HgIn E{SSRD(2 * l), wsp<bf16>(F.ws, WS_QB), wsp<bf16>(F.ws, WS_KB), wsp<bf16>(F.ws, WS_VB), wsp<bf16>(F.ws, WS_GB), wsp<float>(F.ws, WS_LF), wsp<float>(F.ws, WS_LBT) + l * 3072};
                if (!(AFLAGS & 4)) epi::side_gemm(F, g.A, g.Bt, g.N, g.K, E); if (!(AFLAGS & 8)) { const epi::Big<epi::HgIn> BE{E}; pg8::gemm_phase<epi::Big<epi::HgIn>, pg8::StaticOrder, true, true>(F.lds, g, S, BE, F.wave); }
            PHASE_END
            PHASE_BEGIN(2)
                if (F.G >= 2) { const int half = F.G / 2;
                    if (F.bid < half) { if (AFLAGS & 1) for (int u = F.bid; u < NB * HH; u += half) hg_prompt_unit(F, l, u); }
                    else { if (AFLAGS & 2) { for (int u = F.bid - half; u < NS * HH; u += F.G - half) hg_sample_unit(F, A.in[2], l, u);
                            __syncthreads(); const int lane_ = lane_id_v(); convert_weights(F, A, l == 0 ? TD_P0 : TD_R0, l == 0 ? TD_R0 : TD_ITEMS, (F.bid - half) * 8 + F.wave, (F.G - half) * 8, (LAS float*)(F.lds + F.wave * 16384), lane_); } } }
                else { for (int u = 0; u < NB * HH; ++u) hg_prompt_unit(F, l, u); for (int u = 0; u < NS * HH; ++u) hg_sample_unit(F, A.in[2], l, u);
                    __syncthreads(); const int lane_ = lane_id_v(); convert_weights(F, A, l == 0 ? TD_P0 : TD_R0, l == 0 ? TD_R0 : TD_ITEMS, F.wave, 8, (LAS float*)(F.lds + F.wave * 16384), lane_); }
            PHASE_END
        } else {
            const int j = l - 2;
            if (j == 1) {
                PHASE_BEGIN(4)
                    pg8::Gemm g{HB, wsp<bf16>(F.ws, WS_WDQ1), MAIN, 512, D}; pg8::StaticOrder S; S.init(MAIN, 512, F.G, F.bid);
                    epi::Dq E{SSRD(6), wsp<bf16>(F.ws, WS_CQB), SSWR(SS_CQ1)};
                    if (!(AFLAGS & 4)) epi::side_gemm(F, g.A, g.Bt, g.N, g.K, E); if (!(AFLAGS & 8)) { const epi::Big<epi::Dq> BE{E}; pg8::gemm_phase<epi::Big<epi::Dq>, pg8::StaticOrder, true, true>(F.lds, g, S, BE, F.wave); }
                PHASE_END
            }
            if (j == 1) {
                PHASE_BEGIN(5)
                pg8::Gemm g{wsp<bf16>(F.ws, WS_CQB), wsp<bf16>(F.ws, WS_WUQ) + (size_t)j * 1536 * QL, MAIN, 1536, QL}; pg8::StaticOrder S; S.init(MAIN, 1536, F.G, F.bid);
                epi::Uq E{SSRD(SS_CQ0 + j), wsp<bf16>(F.ws, WS_QN), wsp<bf16>(F.ws, WS_QR), rope};
                if (!(AFLAGS & 4)) epi::side_gemm(F, g.A, g.Bt, g.N, g.K, E); if (!(AFLAGS & 8)) { const epi::Big<epi::Uq> BE{E}; pg8::gemm_phase<epi::Big<epi::Uq>, pg8::StaticOrder, true, true>(F.lds, g, S, BE, F.wave); }
                PHASE_END
            }
            PHASE_BEGIN(6)
                gu32* qctr = (gu32*)(A.ws + WS_CTL) + 8192 + 64 * (j + ((AFLAGS & 32) ? 2 : 0)); volatile LAS int* qslot = (volatile LAS int*)(F.lds + LDSCTL_OFF + 128);
                for (;;) {
                    if (F.wave == 0 && lane_id_v() == 0) *qslot = (int)__hip_atomic_fetch_add(qctr, 1u, __ATOMIC_RELAXED, __HIP_MEMORY_SCOPE_AGENT);
                    __syncthreads();
                    const int idx = __builtin_amdgcn_readfirstlane(*qslot);
                    __syncthreads();
                    if (idx >= 1288) break;
                    if (idx < 512 && (idx & 1)) { if (AFLAGS & 2) attn_decode_unit(F, A, idx >> 2, (idx >> 1) & 1); }
                    else if (AFLAGS & 1) { const bool meta = idx >= 1280; const int pi = idx < 512 ? (idx >> 1) : idx - 256; const int bh = pi & 127, qb = 7 - (pi >> 7);
                        attn_prefill_unit(F, meta ? AttnUnit{0, idx - 1280, 0, 1} : AttnUnit{bh >> 3, bh & 7, qb, 0}); }
                }
            PHASE_END
            PHASE_BEGIN(13)
                for (int n = F.bid; n < NS; n += F.G) attn_combine_unit(F, A, n);
            PHASE_END
        }
        PHASE_BEGIN(7)
            pg8::Gemm g{l < 2 ? wsp<bf16>(F.ws, WS_OB) : wsp<bf16>(F.ws, WS_AO), l < 2 ? wsp<bf16>(F.ws, WS_WHO) + (size_t)l * D * D : wsp<bf16>(F.ws, WS_WO) + (size_t)(l - 2) * D * D, MAIN, D, D};
            pg8::StaticOrder S; S.init(MAIN, D, F.G, F.bid);
            if (l == 0) { const epi::ResT<true> E{A.in[0], HB, SSWR(2 * l + 1), AFLAGS & 16, A.in[6], A.in[1]};
                if (!(AFLAGS & 4)) epi::side_gemm(F, g.A, g.Bt, g.N, g.K, E); if (!(AFLAGS & 8)) { const epi::Big<epi::ResT<true>> BE{E}; pg8::gemm_phase<epi::Big<epi::ResT<true>>, pg8::StaticOrder, true, true>(F.lds, g, S, BE, F.wave); } }
            else { const epi::ResT<false> E{nullptr, HB, SSWR(2 * l + 1), AFLAGS & 16, nullptr, nullptr};
                if (!(AFLAGS & 4)) epi::side_gemm(F, g.A, g.Bt, g.N, g.K, E); if (!(AFLAGS & 8)) { const epi::Big<epi::ResT<false>> BE{E}; pg8::gemm_phase<epi::Big<epi::ResT<false>>, pg8::StaticOrder, true, true>(F.lds, g, S, BE, F.wave); } }
        PHASE_END
        PHASE_BEGIN(8)
            pg8::Gemm g{HB, wsp<bf16>(F.ws, WS_WUP) + (size_t)l * FF * D, MAIN, FF, D}; pg8::StaticOrder S; S.init(MAIN, FF, F.G, F.bid);
            epi::Up E{SSRD(2 * l + 1), wsp<bf16>(F.ws, WS_HID)};
            if (!(AFLAGS & 4)) epi::side_gemm(F, g.A, g.Bt, g.N, g.K, E); if (!(AFLAGS & 8)) { const epi::Big<epi::Up> BE{E}; pg8::gemm_phase<epi::Big<epi::Up>, pg8::StaticOrder, true, true>(F.lds, g, S, BE, F.wave); }
        PHASE_END
        PHASE_BEGIN(9)
            pg8::Gemm g{wsp<bf16>(F.ws, WS_HID), wsp<bf16>(F.ws, WS_WDN) + (size_t)l * FF * D, MAIN, D, FF}; pg8::StaticOrder S; S.init(MAIN, D, F.G, F.bid);
            const epi::ResT<false> E{nullptr, HB, SSWR(2 * l + 2), AFLAGS & 16, nullptr, nullptr};
            if (!(AFLAGS & 4)) epi::side_gemm(F, g.A, g.Bt, g.N, g.K, E); if (!(AFLAGS & 8)) { const epi::Big<epi::ResT<false>> BE{E}; pg8::gemm_phase<epi::Big<epi::ResT<false>>, pg8::StaticOrder, true, true>(F.lds, g, S, BE, F.wave); }
        PHASE_END
        if (l == 1) {
            PHASE_BEGIN(10)
                pg8::Gemm g{HB, wsp<bf16>(F.ws, WS_WKVQ), MAIN, 768, D}; pg8::StaticOrder S; S.init(MAIN, 768, F.G, F.bid);
                epi::KvQ E{SSRD(4), wsp<float>(F.ws, WS_CKVF), wsp<bf16>(F.ws, WS_CKVB), wsp<float>(F.ws, WS_KRF), wsp<bf16>(F.ws, WS_KRB), wsp<bf16>(F.ws, WS_CQB), SSWR(SS_CKV), SSWR(SS_CQ0), rope};
                if (!(AFLAGS & 4)) epi::side_gemm(F, g.A, g.Bt, g.N, g.K, E); if (!(AFLAGS & 8)) { const epi::Big<epi::KvQ> BE{E}; pg8::gemm_phase<epi::Big<epi::KvQ>, pg8::StaticOrder, true, true>(F.lds, g, S, BE, F.wave); }
            PHASE_END
            PHASE_BEGIN(11)
                pg8::Gemm g{wsp<bf16>(F.ws, WS_CKVB), wsp<bf16>(F.ws, WS_WUKV), MAIN, 2048, KVL}; pg8::StaticOrder S; S.init(MAIN, 2048, F.G, F.bid);
                epi::KvUp E{SSRD(SS_CKV), wsp<bf16>(F.ws, WS_KN), wsp<bf16>(F.ws, WS_VV)};
                if (!(AFLAGS & 4)) epi::side_gemm(F, g.A, g.Bt, g.N, g.K, E); if (!(AFLAGS & 8)) { const epi::Big<epi::KvUp> BE{E}; pg8::gemm_phase<epi::Big<epi::KvUp>, pg8::StaticOrder, true, true>(F.lds, g, S, BE, F.wave); }
                kv_outputs(F, A.in[19]);
                pg8::Gemm g2{wsp<bf16>(F.ws, WS_CQB), wsp<bf16>(F.ws, WS_WUQ) + (size_t)0 * 1536 * QL, MAIN, 1536, QL}; pg8::StaticOrder S2; S2.init(MAIN, 1536, F.G, F.bid);
                epi::Uq E2{SSRD(SS_CQ0 + 0), wsp<bf16>(F.ws, WS_QN), wsp<bf16>(F.ws, WS_QR), rope};
                if (!(AFLAGS & 4)) epi::side_gemm(F, g2.A, g2.Bt, g2.N, g2.K, E2); if (!(AFLAGS & 8)) { const epi::Big<epi::Uq> BE2{E2}; pg8::gemm_phase<epi::Big<epi::Uq>, pg8::StaticOrder, true, true>(F.lds, g2, S2, BE2, F.wave); }
            PHASE_END
        }
    }
    PHASE_BEGIN(12) final_norm(F, A.in[9]); PHASE_END_LAST
}

#ifndef REPEAT_FLAGS
#define REPEAT_FLAGS 3
#endif
#ifndef N_LAUNCH_MODE
#define N_LAUNCH_MODE 1
#endif
extern "C" void kernel_launch(void* const* d_in, const int* in_sizes, int n_in, void* d_out, int out_size, void* d_ws, size_t ws_size, hipStream_t stream) {
    static int grid = 0;
    if (grid == 0) {
        if (n_in != 29 || out_size != (int)O_END || ws_size < WS_END) { fprintf(stderr, "kernel_launch: unexpected shapes (n_in %d, out %d, ws %zu < %zu)\n", n_in, out_size, ws_size, (size_t)WS_END); grid = -1; return; }
        int dev = 0, cus = 0, per_cu = 0;
        if (hipGetDevice(&dev) != hipSuccess || hipDeviceGetAttribute(&cus, hipDeviceAttributeMultiprocessorCount, dev) != hipSuccess) { grid = -1; return; }
        if (hipFuncSetAttribute((const void*)yoco_fwd, hipFuncAttributeMaxDynamicSharedMemorySize, LDS_BYTES) != hipSuccess) { fprintf(stderr, "kernel_launch: hipFuncSetAttribute failed\n"); grid = -1; return; }
        if (hipOccupancyMaxActiveBlocksPerMultiprocessor(&per_cu, (const void*)yoco_fwd, 512, LDS_BYTES) != hipSuccess || per_cu < 1) fprintf(stderr, "kernel_launch: occupancy query says %d\n", per_cu);
        (void)hipGetLastError();
        grid = cus;
    }
    if (grid < 0) return;
    (void)hipMemsetAsync((char*)d_ws + WS_CTL, 0, CTL_BYTES, stream);
    Args a{};
    for (int i = 0; i < 29; ++i) a.in[i] = (const float*)d_in[i];
    a.out = (float*)d_out; a.ws = (unsigned char*)d_ws; a.flags = 3;
    if (N_LAUNCH_MODE == 1) { a.ph_lo = 0; a.ph_hi = NPH; hipLaunchKernelGGL(yoco_fwd, dim3(grid), dim3(512), LDS_BYTES, stream, a); }
    else for (int p = 0; p < NPH; ++p) { a.ph_lo = p; a.ph_hi = p + 1; const int reps = ((REPEAT_MASK >> p) & 1ull) ? 2 : 1;
        for (int r = 0; r < reps; ++r) { a.flags = r ? REPEAT_FLAGS : 3; static_assert(PROBE_BUILD || N_LAUNCH_MODE == 1, "multi-launch needs PROBE_BUILD"); hipLaunchKernelGGL(yoco_fwd, dim3(grid), dim3(512), LDS_BYTES, stream, a); } }
}
```

```cpp
#include <hip/hip_runtime.h>
#include <cstdio>
#include <cstdint>
#include <cmath>

#define GAS __attribute__((address_space(1)))
#define LAS __attribute__((address_space(3)))
typedef unsigned short bf16;
typedef unsigned v4u __attribute__((ext_vector_type(4)));
typedef unsigned v2u __attribute__((ext_vector_type(2)));
typedef float f32x4 __attribute__((ext_vector_type(4)));
typedef float f32x2 __attribute__((ext_vector_type(2)));
typedef short bf16x8 __attribute__((ext_vector_type(8)));
typedef short s16x4 __attribute__((ext_vector_type(4)));
typedef GAS unsigned gu32;
#define RLX_AGENT __ATOMIC_RELAXED, __HIP_MEMORY_SCOPE_AGENT

#ifndef PROBE_BUILD
#define PROBE_BUILD 0
#endif
#if PROBE_BUILD
#define AFLAGS (A.flags)
#else
#define AFLAGS 3
#endif
constexpr int D = 1024, NB = 16, T = 2048, NMETA = 16, NS = 128, FF = 4096;
constexpr int MAIN = NB * T;
constexpr int SIDE = MAIN;
constexpr int NSIDE = NMETA + NS;
constexpr int M = MAIN + 256;
constexpr int HH = 8, HK = 128, HV = 128;
constexpr int KVL = 256, QL = 384, NOPE = 128, ROPE = 64, VD = 128, PAST = 8192, PAGE = 128, NPG = PAST / PAGE;
constexpr float EPS = 1e-6f;
constexpr float ATT_C = 0.07216878364870322f * 1.4426950408889634f;
constexpr int LPROMPT = NMETA + T;
constexpr int ROPE_SLOTS = LPROMPT + 1;

constexpr size_t O_Y = 0, O_YS = O_Y + (size_t)NB * T * D, O_SP = O_YS + (size_t)NS * D, O_CKVP = O_SP + (size_t)2 * NB * HH * HK * HV,
                 O_KRP = O_CKVP + (size_t)NB * LPROMPT * KVL, O_SS = O_KRP + (size_t)NB * LPROMPT * ROPE, O_CKVS = O_SS + (size_t)2 * NS * HH * HK * HV,
                 O_KRS = O_CKVS + (size_t)NS * KVL, O_END = O_KRS + (size_t)NS * ROPE;
static_assert(O_END == 82042880, "output size");

constexpr size_t al(size_t x) { return (x + 4095) & ~(size_t)4095; }
constexpr size_t WS_CTL = 0, CTL_BYTES = 1u << 20;
constexpr size_t WS_WIN = WS_CTL + CTL_BYTES;
constexpr size_t WS_WHO = WS_WIN + (size_t)2 * 4096 * 1024 * 2;
constexpr size_t WS_WUP = WS_WHO + (size_t)2 * 1024 * 1024 * 2;
constexpr size_t WS_WDN = WS_WUP + (size_t)4 * 4096 * 1024 * 2;
constexpr size_t WS_WKVQ = WS_WDN + (size_t)4 * 4096 * 1024 * 2;
constexpr size_t WS_WDQ1 = WS_WKVQ + (size_t)768 * 1024 * 2;
constexpr size_t WS_WUQ = WS_WDQ1 + (size_t)512 * 1024 * 2;
constexpr size_t WS_WO = WS_WUQ + (size_t)2 * 1536 * 384 * 2;
constexpr size_t WS_WUKV = WS_WO + (size_t)2 * 1024 * 1024 * 2;
constexpr size_t WS_ROPE = al(WS_WUKV + (size_t)2048 * 256 * 2);
constexpr size_t WS_LBT = al(WS_ROPE + (size_t)ROPE_SLOTS * 64 * 4);
constexpr size_t WS_SS = al(WS_LBT + (size_t)2 * 3 * 1024 * 4);
constexpr int NSS = 12;
constexpr size_t WS_H = al(WS_SS + (size_t)NSS * M * 4);
constexpr size_t WS_HB = al(WS_H + (size_t)M * D * 4);
constexpr size_t WS_QB = al(WS_HB + (size_t)M * D * 2);
constexpr size_t WS_KB = al(WS_QB + (size_t)M * D * 2);
constexpr size_t WS_VB = al(WS_KB + (size_t)M * D * 2);
constexpr size_t WS_GB = al(WS_VB + (size_t)M * D * 2);
constexpr size_t WS_LF = al(WS_GB + (size_t)M * D * 2);
constexpr size_t WS_ORAW = al(WS_LF + (size_t)M * D * 4);
constexpr size_t WS_OB = al(WS_ORAW + (size_t)M * D * 4);
constexpr size_t WS_HID = al(WS_OB + (size_t)M * D * 2);
constexpr size_t WS_CKVF = al(WS_HID + (size_t)M * FF * 2);
constexpr size_t WS_CKVB = al(WS_CKVF + (size_t)M * KVL * 4);
constexpr size_t WS_KRF = al(WS_CKVB + (size_t)M * KVL * 2);
constexpr size_t WS_KRB = al(WS_KRF + (size_t)M * ROPE * 4);
constexpr size_t WS_CQB = al(WS_KRB + (size_t)M * ROPE * 2);
constexpr size_t WS_QN = al(WS_CQB + (size_t)M * QL * 2);
constexpr size_t WS_QR = al(WS_QN + (size_t)M * D * 2);
constexpr size_t WS_KN = al(WS_QR + (size_t)M * 512 * 2);
constexpr size_t WS_VV = al(WS_KN + (size_t)M * D * 2);
constexpr size_t WS_AO = al(WS_VV + (size_t)M * D * 2);
constexpr size_t WS_PART = al(WS_AO + (size_t)M * D * 2);
constexpr size_t WS_SSP = al(WS_PART + (size_t)2 * NS * 4 * 2112 * 4);
constexpr size_t WS_SSPS = al(WS_SSP + (size_t)12 * 32768 * 16 * 4);
constexpr size_t WS_END = al(WS_SSPS + (size_t)12 * 256 * 64 * 4);
enum { SS_H0 = 0, SS_CKV = 9, SS_CQ0 = 10, SS_CQ1 = 11 };

constexpr int RING_BYTES = 131072, LDSCTL_OFF = RING_BYTES, LDS_BYTES = 147456;

#define LDS_WAIT() asm volatile("s_waitcnt lgkmcnt(0)" ::: "memory")
#define VM_WAIT() asm volatile("s_waitcnt vmcnt(0)" ::: "memory")
__device__ __forceinline__ unsigned f2bf(float f) { unsigned u = __builtin_bit_cast(unsigned, f); return (u + 0x7fffu + ((u >> 16) & 1u)) >> 16; }
typedef __bf16 bf16x2_t __attribute__((ext_vector_type(2)));
__device__ __forceinline__ unsigned pk2(float lo, float hi) { const f32x2 v = {lo, hi}; return __builtin_bit_cast(unsigned, __builtin_convertvector(v, bf16x2_t)); }
__device__ __forceinline__ float bf2f(unsigned short b) { return __builtin_bit_cast(float, (unsigned)b << 16); }
__device__ __forceinline__ float bflo(unsigned w) { return __builtin_bit_cast(float, w << 16); }
__device__ __forceinline__ float bfhi(unsigned w) { return __builtin_bit_cast(float, w & 0xffff0000u); }
__device__ __forceinline__ float rstd_of(float ss, float inv_n) { return __builtin_amdgcn_rsqf(ss * inv_n + EPS); }
__device__ __forceinline__ int pos_slot(int row) { return row < MAIN ? NMETA + (row & (T - 1)) : (row - SIDE < NMETA ? row - SIDE : (row - SIDE < NSIDE ? LPROMPT : 0)); }
__device__ __forceinline__ int lane_id_v() { int l; asm volatile("v_mbcnt_lo_u32_b32 %0, -1, 0\n\tv_mbcnt_hi_u32_b32 %0, -1, %0" : "=v"(l)); return l; }
__device__ __forceinline__ f32x4 mfma16(bf16x8 a, bf16x8 b, f32x4 c) { return __builtin_amdgcn_mfma_f32_16x16x32_bf16(a, b, c, 0, 0, 0); }
__device__ __forceinline__ s16x4 tr_rd(LAS unsigned char* p) { return __builtin_amdgcn_ds_read_tr16_b64_v4i16((LAS s16x4*)p); }
__device__ __forceinline__ bf16x8 cat4(s16x4 lo, s16x4 hi) { bf16x8 r = {lo[0], lo[1], lo[2], lo[3], hi[0], hi[1], hi[2], hi[3]}; return r; }
__device__ __forceinline__ bf16x8 pack8(f32x4 a, f32x4 b) { v4u w; w.x = pk2(a[0], a[1]); w.y = pk2(a[2], a[3]); w.z = pk2(b[0], b[1]); w.w = pk2(b[2], b[3]); return __builtin_bit_cast(bf16x8, w); }
__device__ __forceinline__ float max4(f32x4 v) { return fmaxf(fmaxf(v[0], v[1]), fmaxf(v[2], v[3])); }
constexpr float NEG = -1e30f;

template <int N> __device__ __forceinline__ float dpp_ror(float x) { return __builtin_bit_cast(float, __builtin_amdgcn_update_dpp(0, __builtin_bit_cast(int, x), 0x120 + N, 0xf, 0xf, false)); }
__device__ __forceinline__ float row_sum16(float x) { x += dpp_ror<8>(x); x += dpp_ror<4>(x); x += dpp_ror<2>(x); x += dpp_ror<1>(x); return x; }
__device__ __forceinline__ float u2f(unsigned u) { return __builtin_bit_cast(float, u); }
__device__ __forceinline__ unsigned f2u(float f) { return __builtin_bit_cast(unsigned, f); }
__device__ __forceinline__ float xg_max(float x) {
    auto s = __builtin_amdgcn_permlane16_swap(f2u(x), f2u(x), false, false); const unsigned s0 = s[0], s1 = s[1];
    x = fmaxf(u2f(s0), u2f(s1));
    auto t = __builtin_amdgcn_permlane32_swap(f2u(x), f2u(x), false, false); const unsigned t0 = t[0], t1 = t[1];
    return fmaxf(u2f(t0), u2f(t1));
}
__device__ __forceinline__ float xg_sum(float x) {
    auto s = __builtin_amdgcn_permlane16_swap(f2u(x), f2u(x), false, false); const unsigned s0 = s[0], s1 = s[1];
    x = u2f(s0) + u2f(s1);
    auto t = __builtin_amdgcn_permlane32_swap(f2u(x), f2u(x), false, false); const unsigned t0 = t[0], t1 = t[1];
    return u2f(t0) + u2f(t1);
}
__device__ __forceinline__ float half_sum(float x) {
    auto t = __builtin_amdgcn_permlane32_swap(f2u(x), f2u(x), false, false); const unsigned t0 = t[0], t1 = t[1];
    return u2f(t0) + u2f(t1);
}
__device__ __forceinline__ float row_scan4(float x, int row) {
    auto s = __builtin_amdgcn_permlane16_swap(f2u(x), f2u(x), false, false); const unsigned s0 = s[0], s1 = s[1];
    const float y = (row & 1) ? u2f(s0) + u2f(s1) : x;
    auto t = __builtin_amdgcn_permlane32_swap(f2u(y), f2u(y), false, false); const unsigned t0 = t[0];
    auto u = __builtin_amdgcn_permlane16_swap(t0, t0, false, false); const unsigned u1 = u[1];
    return (row & 2) ? y + u2f(u1) : y;
}
struct SSR { const float* m; const float* s; };
struct SSW { float* m; float* s; };
__device__ __forceinline__ float ss_get(const SSR r, int row) {
    if (row < SIDE) { const f32x4* p = (const f32x4*)(r.m + (size_t)row * 16); const f32x4 a = p[0] + p[1], b = p[2] + p[3]; const f32x4 c = a + b; return (c[0] + c[1]) + (c[2] + c[3]); }
    const f32x4* p = (const f32x4*)(r.s + (size_t)(row - SIDE) * 64); f32x4 c = p[0];
#pragma unroll
    for (int i = 1; i < 16; ++i) c += p[i];
    return (c[0] + c[1]) + (c[2] + c[3]);
}
#define XB_TMO      128
#define XB_XCNT(j)  (256  + 64 * (j))
#define XB_XSUB(j)  (1280 + 64 * (j))
#define XB_XGEN(j)  (2304 + 64 * (j))
#define XB_TOP      3328
#define XB_TOPGEN   3392
#define XCD_BAR_WORDS 3456
#define XB_SPIN_CAP (1u << 18)

__device__ __forceinline__ unsigned xb_ld(unsigned* p)              { return __hip_atomic_load(p, __ATOMIC_RELAXED, __HIP_MEMORY_SCOPE_AGENT); }
__device__ __forceinline__ unsigned xb_add(unsigned* p, unsigned v) { return __hip_atomic_fetch_add(p, v, __ATOMIC_RELAXED, __HIP_MEMORY_SCOPE_AGENT); }
__device__ __forceinline__ unsigned xb_xcc_id() { return (unsigned)__builtin_amdgcn_s_getreg((3 << 11) | 20) & 0xFu; }
#define XB_SPIN(cond, bar) do { unsigned _sp = 0; while (cond) { __builtin_amdgcn_s_sleep(1); \
    if ((++_sp & 255u) == 0u) { if (xb_ld(&(bar)[XB_TMO])) break; if (_sp > XB_SPIN_CAP) { atomicAdd(&(bar)[XB_TMO], 1u); break; } } } } while (0)

struct XcdBarrier {
    unsigned* bar; unsigned x;
    volatile LAS unsigned* st;
};

__device__ __forceinline__ XcdBarrier xcd_barrier_post(unsigned* bar, volatile LAS unsigned* st) {
    XcdBarrier b; b.bar = bar; b.x = xb_xcc_id(); b.st = st;
    if (threadIdx.x == 0) (void)xb_add(&bar[XB_XCNT(b.x)], 1u);
    return b;
}
__device__ __forceinline__ void xcd_barrier_complete(unsigned* bar, unsigned x, unsigned& nloc, unsigned& nx) {
    const unsigned G = gridDim.x * gridDim.y * gridDim.z;
    unsigned sum, cnt, mine, sp = 0u;
    for (;;) {
        sum = 0u; cnt = 0u; mine = 0u;
#pragma unroll
        for (unsigned j = 0; j < 16; ++j) { const unsigned c = xb_ld(&bar[XB_XCNT(j)]); sum += c; cnt += (c > 0u) ? 1u : 0u; mine = (j == x) ? c : mine; }
        if (sum == G) break;
        __builtin_amdgcn_s_sleep(1);
        if ((++sp & 255u) == 0u) { if (xb_ld(&bar[XB_TMO])) break; if (sp > XB_SPIN_CAP) { atomicAdd(&bar[XB_TMO], 1u); break; } }
    }
    nloc = mine > 0u ? mine : 1u; nx = cnt > 0u ? cnt : 1u;
}

__device__ __forceinline__ void xcd_barrier(const XcdBarrier& b) {
    asm volatile("s_waitcnt vmcnt(0)" ::: "memory");
    __syncthreads();
    if (threadIdx.x == 0) {
        unsigned* bar = b.bar;
        __builtin_amdgcn_s_waitcnt(0);
        unsigned nloc = b.st[0], nx = b.st[1];
        if (nloc == 0u) { xcd_barrier_complete(bar, b.x, nloc, nx); b.st[0] = nloc; b.st[1] = nx; }
        const unsigned old = xb_add(&bar[XB_XSUB(b.x)], 1u);
        const unsigned gen = old / nloc;
        if (old + 1u == (gen + 1u) * nloc) {
            __builtin_amdgcn_fence(__ATOMIC_RELEASE, "agent");
            asm volatile("s_waitcnt vmcnt(0)" ::: "memory");
            const unsigned og = xb_add(&bar[XB_TOP], 1u);
            const unsigned tg = og / nx;
            if (og + 1u == (tg + 1u) * nx) xb_add(&bar[XB_TOPGEN], 1u);
            else XB_SPIN(xb_ld(&bar[XB_TOPGEN]) == tg, bar);
            __builtin_amdgcn_fence(__ATOMIC_ACQUIRE, "agent");
            xb_add(&bar[XB_XGEN(b.x)], 1u);
            asm volatile("s_waitcnt vmcnt(0)" ::: "memory");
        } else {
            XB_SPIN(xb_ld(&bar[XB_XGEN(b.x)]) == gen, bar);
            __builtin_amdgcn_fence(__ATOMIC_ACQUIRE, "agent");
            asm volatile("s_waitcnt vmcnt(0)" ::: "memory");
        }
    }
    __syncthreads();
}
namespace pg8 {
#define PG8_LAS __attribute__((address_space(3)))
typedef unsigned short bf16_t;
typedef short bf16x8 __attribute__((ext_vector_type(8)));
typedef float f32x4 __attribute__((ext_vector_type(4)));
typedef unsigned u32x4 __attribute__((ext_vector_type(4)));
constexpr int BM = 256, BK = 64, HALF = 128, HTB = HALF * BK * 2  , STAGE_BYTES = 8 * HTB, NXCD = 8, WGM = 8;

__host__ __device__ __forceinline__ int lds_byte(int r, int c) { const int st = (r >> 4) * 2 + (c >> 5), rr = r & 15, cc = c & 31, ob = rr * 64 + cc * 2; return st * 1024 + (ob ^ (((ob >> 9) & 1) << 5)); }
__host__ __device__ __forceinline__ void stage_rc(int b, int& R, int& C) { const int st = b / 1024, sb = b % 1024, swz = sb ^ (((sb >> 9) & 1) << 5); R = (st >> 1) * 16 + swz / 64; C = (st & 1) * 32 + (swz % 64) / 2; }
__host__ __device__ __forceinline__ int perm32(int rho) { const int n = rho >> 4, i = rho & 15; return 8 * (i >> 2) + 4 * n + (i & 3); }
__host__ __device__ __forceinline__ int perm256(int R) { const int wc = R >> 5, n = (R >> 4) & 1, i = R & 15; return 64 * wc + 16 * (i >> 2) + 4 * n + (i & 3); }

struct Unit { int pm, pn; };
struct Gemm { const bf16_t* A; const bf16_t* Bt; int M, N, K; };

struct StaticOrder {
    int nM, nN, nwg, G, c;
    __host__ __device__ void init(int M, int N, int G_, int c_) { nM = M / BM; nN = N / BM; nwg = nM * nN; G = G_; c = c_; }
    __host__ __device__ bool next(int i, Unit& u) const {
        const long L = (long)i * G + c; if (L >= nwg) return false;
        int wgid = (int)L; { const int q = nwg / NXCD, r = nwg % NXCD, xcd = wgid % NXCD, off = wgid / NXCD; wgid = (xcd < r ? xcd * (q + 1) : r * (q + 1) + (xcd - r) * q) + off; }
        const int nig = WGM * nN, gid = wgid / nig, fm = gid * WGM, gsz = (nM - fm) < WGM ? (nM - fm) : WGM;
        u.pm = fm + ((wgid % nig) % gsz); u.pn = (wgid % nig) / gsz; return true;
    }
    __device__ __forceinline__ void a_ready(const Unit&) const {}
    __device__ __forceinline__ void done(const Unit&) const {}
};

template <class Epi, class Sched, bool ALIGN_EPI = false, bool SP2 = false>
__device__ __forceinline__ void gemm_phase(PG8_LAS unsigned char* lds, const Gemm g, const Sched& S, const Epi& E, const int wave_sgpr) {
    int tid_ = wave_sgpr * 64 + lane_id_v();
    const int tid = tid_, wid = __builtin_amdgcn_readfirstlane(tid >> 6), lane = tid & 63, wr = wid >> 2, wc = wid & 3, fr = lane & 15, fq = lane >> 4;
    const int K = g.K, nt = K / BK;
    unsigned voffA[2], voffB[2];
#pragma unroll
    for (int i = 0; i < 2; ++i) { int R, C; stage_rc(tid * 16 + i * 8192, R, C); const int Rb = Epi::PERM ? perm256(R) : R;
        voffA[i] = (unsigned)(R * K + C) * 2u; voffB[i] = (unsigned)(Rb * K + C) * 2u; }
    const size_t kstep = (size_t)(BK * 2);
    const size_t hstep = (size_t)HALF * K * 2;
    const size_t hstepB = Epi::PERM ? (size_t)8 * K * 2 : hstep;
    const size_t tstep = 2 * hstep;
    const unsigned ldsw = (unsigned)wid * 1024u;
    const int aoff = lds_byte(wr * 64 + fr, fq * 8), boff = lds_byte(wc * 32 + fr, fq * 8);
#define PG8_SA(b, h) (((b) * 2 + (h)) * HTB)
#define PG8_SB(b, h) ((4 + (b) * 2 + (h)) * HTB)
#define PG8_STAGE(bufoff, gbase, voff) do { _Pragma("unroll") for (int _i = 0; _i < 2; ++_i) \
        __builtin_amdgcn_global_load_lds((const unsigned*)((const char*)(gbase) + (voff)[_i]), (PG8_LAS unsigned*)(lds + (bufoff) + ldsw + _i * 8192), 16, 0, 0); } while (0)
#define PG8_LDA(dst, b, h) do { _Pragma("unroll") for (int m = 0; m < 4; ++m) _Pragma("unroll") for (int k = 0; k < 2; ++k) dst[m][k] = *(const PG8_LAS bf16x8*)(lds + PG8_SA(b, h) + aoff + m * 2048 + k * 1024); } while (0)
#define PG8_LDB(dst, b, h) do { _Pragma("unroll") for (int n = 0; n < 2; ++n) _Pragma("unroll") for (int k = 0; k < 2; ++k) dst[n][k] = *(const PG8_LAS bf16x8*)(lds + PG8_SB(b, h) + boff + n * 2048 + k * 1024); } while (0)
#define PG8_MMA(ai, bj, At, Bt) do { __builtin_amdgcn_s_setprio(1); _Pragma("unroll") for (int m = 0; m < 4; ++m) _Pragma("unroll") for (int n = 0; n < 2; ++n) _Pragma("unroll") for (int k = 0; k < 2; ++k) \
        acc[ai][bj][m][n] = __builtin_amdgcn_mfma_f32_16x16x32_bf16(Bt[n][k], At[m][k], acc[ai][bj][m][n], 0, 0, 0); __builtin_amdgcn_s_setprio(0); } while (0)
#define PG8_WAIT_V(n) asm volatile("s_waitcnt vmcnt(" #n ")" ::: "memory")
#define PG8_WAIT_L(n) asm volatile("s_waitcnt lgkmcnt(" #n ")" ::: "memory")
#define PG8_BAR __builtin_amdgcn_s_barrier()
#define PG8_SCHED __builtin_amdgcn_sched_barrier(0)
    Unit cur, nxt; int ui = 0;
    if (!S.next(0, cur)) return;
    f32x4 acc[2][2][4][2];
#pragma unroll
    for (int a = 0; a < 2; ++a)
#pragma unroll
        for (int b = 0; b < 2; ++b)
#pragma unroll
            for (int m = 0; m < 4; ++m)
#pragma unroll
                for (int n = 0; n < 2; ++n) acc[a][b][m][n] = (f32x4){0.f, 0.f, 0.f, 0.f};
    bf16x8 At[4][2], B0[2][2], B1[2][2];
    const char* cA = (const char*)g.A + (size_t)cur.pm * tstep; const char* cB = (const char*)g.Bt + (size_t)cur.pn * tstep;
    S.a_ready(cur);
    if constexpr (SP2) {
        PG8_STAGE(PG8_SB(0, 0), cB, voffB); PG8_STAGE(PG8_SB(0, 1), cB + hstepB, voffB); PG8_STAGE(PG8_SA(0, 0), cA, voffA); PG8_STAGE(PG8_SA(0, 1), cA + hstep, voffA);
        if (wr == 1) PG8_BAR;
        PG8_WAIT_V(2); PG8_BAR;
        PG8_STAGE(PG8_SB(1, 0), cB + kstep, voffB); PG8_STAGE(PG8_SA(1, 0), cA + kstep, voffA); PG8_STAGE(PG8_SB(1, 1), cB + hstepB + kstep, voffB);
        PG8_WAIT_V(6); PG8_BAR;
    } else {
        PG8_STAGE(PG8_SB(0, 0), cB, voffB); PG8_STAGE(PG8_SA(0, 0), cA, voffA); PG8_STAGE(PG8_SB(0, 1), cB + hstepB, voffB); PG8_STAGE(PG8_SA(0, 1), cA + hstep, voffA);
        if (wr == 1) PG8_BAR;
        PG8_WAIT_V(4); PG8_BAR;
        PG8_STAGE(PG8_SB(1, 0), cB + kstep, voffB); PG8_STAGE(PG8_SA(1, 0), cA + kstep, voffA); PG8_STAGE(PG8_SB(1, 1), cB + hstepB + kstep, voffB);
        PG8_WAIT_V(6); PG8_BAR;
    }
    for (;;) {
        const bool has_next = S.next(ui + 1, nxt);
        const char* nA = has_next ? (const char*)g.A + (size_t)nxt.pm * tstep : cA; const char* nB = has_next ? (const char*)g.Bt + (size_t)nxt.pn * tstep : cB;
        for (int t = 0; t < nt; t += 2) {
            const bool last = (t == nt - 2);
            const char* a1 = cA + (size_t)(t + 1) * kstep;
            const char* a2 = last ? nA : cA + (size_t)(t + 2) * kstep; const char* b2 = last ? nB : cB + (size_t)(t + 2) * kstep;
            const char* a3 = a2 + kstep; const char* b3 = b2 + kstep;
            if (last && has_next) S.a_ready(nxt);
            if constexpr (SP2) {
            PG8_LDB(B0, 0, 0); PG8_LDB(B1, 0, 1); PG8_SCHED; PG8_LDA(At, 0, 0); PG8_STAGE(PG8_SA(1, 1), a1 + hstep, voffA);
            PG8_WAIT_V(8); PG8_WAIT_L(0); PG8_BAR; PG8_MMA(0, 0, At, B0); PG8_MMA(0, 1, At, B1); PG8_BAR; PG8_SCHED;
            PG8_LDA(At, 0, 1); PG8_STAGE(PG8_SB(0, 0), b2, voffB); PG8_STAGE(PG8_SB(0, 1), b2 + hstepB, voffB); PG8_STAGE(PG8_SA(0, 0), a2, voffA);
            PG8_WAIT_V(8); PG8_WAIT_L(0); PG8_BAR; PG8_MMA(1, 0, At, B0); PG8_MMA(1, 1, At, B1); PG8_BAR; PG8_SCHED;
            PG8_LDB(B0, 1, 0); PG8_LDB(B1, 1, 1); PG8_SCHED; PG8_LDA(At, 1, 0); PG8_STAGE(PG8_SA(0, 1), a2 + hstep, voffA);
            PG8_WAIT_V(8); PG8_WAIT_L(0); PG8_BAR; PG8_MMA(0, 0, At, B0); PG8_MMA(0, 1, At, B1); PG8_BAR; PG8_SCHED;
            PG8_LDA(At, 1, 1); PG8_STAGE(PG8_SB(1, 0), b3, voffB); PG8_STAGE(PG8_SB(1, 1), b3 + hstepB, voffB); PG8_STAGE(PG8_SA(1, 0), a3, voffA);
            PG8_WAIT_V(8); PG8_WAIT_L(0); PG8_BAR; PG8_MMA(1, 0, At, B0); PG8_MMA(1, 1, At, B1); PG8_BAR; PG8_SCHED;
            } else {
            PG8_LDB(B0, 0, 0); PG8_SCHED; PG8_LDA(At, 0, 0); PG8_STAGE(PG8_SA(1, 1), a1 + hstep, voffA);
            PG8_WAIT_L(8); PG8_BAR; PG8_WAIT_L(0); PG8_MMA(0, 0, At, B0); PG8_BAR; PG8_SCHED;
            PG8_LDB(B1, 0, 1); PG8_STAGE(PG8_SB(0, 0), b2, voffB);
            PG8_BAR; PG8_WAIT_L(0); PG8_MMA(0, 1, At, B1); PG8_BAR;
            PG8_LDA(At, 0, 1); PG8_STAGE(PG8_SA(0, 0), a2, voffA);
            PG8_BAR; PG8_WAIT_L(0); PG8_MMA(1, 0, At, B0); PG8_BAR; PG8_SCHED;
            PG8_STAGE(PG8_SB(0, 1), b2 + hstepB, voffB);
            PG8_WAIT_V(6); PG8_BAR; PG8_MMA(1, 1, At, B1); PG8_BAR;
            PG8_LDB(B0, 1, 0); PG8_SCHED; PG8_LDA(At, 1, 0); PG8_STAGE(PG8_SA(0, 1), a2 + hstep, voffA);
            PG8_WAIT_L(8); PG8_BAR; PG8_WAIT_L(0); PG8_MMA(0, 0, At, B0); PG8_BAR; PG8_SCHED;
            PG8_LDB(B1, 1, 1); PG8_STAGE(PG8_SB(1, 0), b3, voffB);
            PG8_BAR; PG8_WAIT_L(0); PG8_MMA(0, 1, At, B1); PG8_BAR;
            PG8_LDA(At, 1, 1); PG8_STAGE(PG8_SA(1, 0), a3, voffA);
            PG8_BAR; PG8_WAIT_L(0); PG8_MMA(1, 0, At, B0); PG8_BAR; PG8_SCHED;
            PG8_STAGE(PG8_SB(1, 1), b3 + hstepB, voffB);
            PG8_WAIT_V(6); PG8_BAR; PG8_MMA(1, 1, At, B1); PG8_BAR;
            }
        }
        if constexpr (ALIGN_EPI) { if (wr == 0) PG8_BAR; }
        if constexpr (!Epi::AFTER_DRAIN) { const int l2_ = lane_id_v(); E(acc, cur, wr, wc, l2_ & 15, l2_ >> 4); S.done(cur); }
        if (!has_next) break;
#pragma unroll
        for (int a = 0; a < 2; ++a)
#pragma unroll
            for (int b = 0; b < 2; ++b)
#pragma unroll
                for (int m = 0; m < 4; ++m)
#pragma unroll
                    for (int n = 0; n < 2; ++n) acc[a][b][m][n] = (f32x4){0.f, 0.f, 0.f, 0.f};
        cur = nxt; cA = nA; cB = nB; ++ui;
        if constexpr (ALIGN_EPI) { if (wr == 1) PG8_BAR; }
    }
    PG8_WAIT_V(0);
    if constexpr (!ALIGN_EPI) { if (wr == 0) PG8_BAR; }
    PG8_BAR;
    if constexpr (Epi::AFTER_DRAIN) { E.fused(acc, cur, wr, wc, fr, fq, lds, wid, lane); S.done(cur); }
#undef PG8_SA
#undef PG8_SB
#undef PG8_STAGE
#undef PG8_LDA
#undef PG8_LDB
#undef PG8_MMA
#undef PG8_WAIT_V
#undef PG8_WAIT_L
#undef PG8_BAR
#undef PG8_SCHED
}
}
struct TDesc { int in_idx, in_off, g_idx, g_off; size_t ws_off; int K, ldw, N, row_off, mode, item0; };
constexpr int NTD = 28;
constexpr int TD_ITEMS = 23904;
constexpr int TD_P0 = 2048, TD_R0 = (TD_ITEMS + TD_P0) / 2;
__device__ const TDesc g_td[NTD] = {
    {10, 0, 7, 0, WS_WIN + (size_t)0 * 2, 1024, 1024, 1024, 0, 0, 0},
    {11, 0, 7, 0, WS_WIN + (size_t)0 * 2, 1024, 1024, 1024, 1024, 0, 512},
    {12, 0, 7, 0, WS_WIN + (size_t)0 * 2, 1024, 1024, 1024, 2048, 0, 1024},
    {13, 0, 7, 0, WS_WIN + (size_t)0 * 2, 1024, 1024, 1024, 3072, 0, 1536},
    {15, 0, 14, 0, WS_WHO + (size_t)0 * 2, 1024, 1024, 1024, 0, 0, 2048},
    {27, 0, 8, 0, WS_WUP + (size_t)0 * 2, 1024, 4096, 4096, 0, 0, 2560},
    {28, 0, -1, 0, WS_WDN + (size_t)0 * 2, 4096, 1024, 1024, 0, 0, 4608},
    {10, 1048576, 7, 1024, WS_WIN + (size_t)4194304 * 2, 1024, 1024, 1024, 0, 0, 6656},
    {11, 1048576, 7, 1024, WS_WIN + (size_t)4194304 * 2, 1024, 1024, 1024, 1024, 0, 7168},
    {12, 1048576, 7, 1024, WS_WIN + (size_t)4194304 * 2, 1024, 1024, 1024, 2048, 0, 7680},
    {13, 1048576, 7, 1024, WS_WIN + (size_t)4194304 * 2, 1024, 1024, 1024, 3072, 0, 8192},
    {15, 1048576, 14, 1024, WS_WHO + (size_t)1048576 * 2, 1024, 1024, 1024, 0, 0, 8704},
    {27, 4194304, 8, 1024, WS_WUP + (size_t)4194304 * 2, 1024, 4096, 4096, 0, 0, 9216},
    {28, 4194304, -1, 0, WS_WDN + (size_t)4194304 * 2, 4096, 1024, 1024, 0, 0, 11264},
    {18, 0, 17, 0, WS_WKVQ + (size_t)0 * 2, 1024, 256, 256, 0, 0, 13312},
    {20, 0, 17, 0, WS_WKVQ + (size_t)0 * 2, 1024, 64, 64, 256, 1, 13440},
    {23, 0, 7, 2048, WS_WKVQ + (size_t)0 * 2, 1024, 384, 384, 320, 0, 13472},
    {21, 0, 19, 0, WS_WUKV + (size_t)0 * 2, 256, 1024, 1024, 0, 0, 13664},
    {22, 0, 19, 0, WS_WUKV + (size_t)0 * 2, 256, 1024, 1024, 1024, 0, 13792},
    {25, 0, 24, 0, WS_WUQ + (size_t)0 * 2, 384, 1536, 1536, 0, 2, 13920},
    {26, 0, -1, 0, WS_WO + (size_t)0 * 2, 1024, 1024, 1024, 0, 0, 14208},
    {27, 8388608, 8, 2048, WS_WUP + (size_t)8388608 * 2, 1024, 4096, 4096, 0, 0, 14720},
    {28, 8388608, -1, 0, WS_WDN + (size_t)8388608 * 2, 4096, 1024, 1024, 0, 0, 16768},
    {23, 393216, 7, 3072, WS_WDQ1 + (size_t)0 * 2, 1024, 384, 384, 0, 0, 18816},
    {25, 589824, 24, 384, WS_WUQ + (size_t)589824 * 2, 384, 1536, 1536, 0, 2, 19008},
    {26, 1048576, -1, 0, WS_WO + (size_t)1048576 * 2, 1024, 1024, 1024, 0, 0, 19296},
    {27, 12582912, 8, 3072, WS_WUP + (size_t)12582912 * 2, 1024, 4096, 4096, 0, 0, 19808},
    {28, 12582912, -1, 0, WS_WDN + (size_t)12582912 * 2, 4096, 1024, 1024, 0, 0, 21856},
};
struct Args { const float* in[29]; float* out; unsigned char* ws; int ph_lo, ph_hi, flags, pad; };
struct Frame {
    LAS unsigned char* lds; int wave, G, bid;
    unsigned char* ws; float* out;
};
#define GAS __attribute__((address_space(1)))
template <class TT> __device__ __forceinline__ TT* wsp(unsigned char* ws, size_t off) { return (TT*)(ws + off); }
__device__ __forceinline__ float wave_sum(float v) { return xg_sum(row_sum16(v)); }
__device__ __forceinline__ int td_dest(int mode, int row_off, int n) {
    if (mode == 0) return row_off + n;
    if (mode == 1) return row_off + (n < 32 ? 2 * n : 2 * (n - 32) + 1);
    const int h = n / 192, d = n - h * 192;
    if (d < 128) return h * 128 + d;
    const int i = d - 128; return 1024 + h * 64 + (i < 32 ? 2 * i : 2 * (i - 32) + 1);
}
__device__ __forceinline__ void transpose_item(const float* __restrict__ W, const float* __restrict__ gain, bf16* WT, int K, int ldw, int N, int row_off, int mode, int item, LAS float* scr, int lane) {
    const int nblk = N / 32, kb = item / nblk, nb = item - kb * nblk, k0 = 64 * kb, n0 = 32 * nb;
#pragma unroll 8
    for (int i = 0; i < 32; ++i) { const int kk = 2 * i + (lane >> 5); float w = W[(size_t)(k0 + kk) * ldw + n0 + (lane & 31)]; if (gain) w *= gain[k0 + kk]; scr[kk * 33 + (lane & 31)] = w; }
    LDS_WAIT(); asm volatile("" ::: "memory");
    const int c = lane & 7;
#pragma unroll
    for (int j = 0; j < 4; ++j) { const int n = (lane >> 3) + 8 * j; const LAS float* s = scr + (8 * c) * 33 + n;
        v4u o; o.x = pk2(s[0 * 33], s[1 * 33]); o.y = pk2(s[2 * 33], s[3 * 33]); o.z = pk2(s[4 * 33], s[5 * 33]); o.w = pk2(s[6 * 33], s[7 * 33]);
        *(v4u*)(WT + (size_t)td_dest(mode, row_off, n0 + n) * K + k0 + 8 * c) = o; }
    LDS_WAIT(); asm volatile("" ::: "memory");
}
__device__ __forceinline__ const float* x_row(const Args& A, int r) { return r < MAIN ? A.in[0] + (size_t)r * D : (r - SIDE < NMETA ? A.in[6] + (size_t)(r - SIDE) * D : A.in[1] + (size_t)(r - SIDE - NMETA) * D); }
__device__ __forceinline__ void convert_weights(const Frame& F, const Args& A, int lo, int hi, int gw, int ngw, LAS float* scr, int lane) {
    for (int it = lo + gw; it < hi; it += ngw) {
        int id = 0;
#pragma unroll 1
        for (int k = 1; k < NTD; ++k) if (it >= g_td[k].item0) id = k;
        const TDesc d = g_td[id];
        const float* W = A.in[d.in_idx] + d.in_off; const float* gain = d.g_idx >= 0 ? A.in[d.g_idx] + d.g_off : nullptr;
        transpose_item(W, gain, (bf16*)(F.ws + d.ws_off), d.K, d.ldw, d.N, d.row_off, d.mode, it - d.item0, scr, lane);
    }
}
__device__ __forceinline__ void p0_prologue(const Frame& F, const Args& A) {
    int tid_ = F.wave * 64 + lane_id_v(); const int lane = tid_ & 63, wave = __builtin_amdgcn_readfirstlane(tid_ >> 6);
    LAS float* scr = (LAS float*)(F.lds + wave * 16384);
    const int gw = F.bid * 8 + wave, NGW = F.G * 8;
    convert_weights(F, A, 0, TD_P0, gw, NGW, scr, lane);
    const size_t gt = (size_t)F.bid * 512 + tid_, NGT = (size_t)F.G * 512;
    { v4u z = {0u, 0u, 0u, 0u};
      v4u* p0 = (v4u*)(F.ws + WS_WKVQ + (size_t)704 * 1024 * 2); for (size_t i = gt; i < (size_t)64 * 1024 * 2 / 16; i += NGT) p0[i] = z;
      v4u* p1 = (v4u*)(F.ws + WS_WDQ1 + (size_t)384 * 1024 * 2); for (size_t i = gt; i < (size_t)128 * 1024 * 2 / 16; i += NGT) p1[i] = z;
      v4u* p2 = (v4u*)(F.ws + WS_SSP + (size_t)MAIN * 64); for (size_t i = gt; i < (size_t)(NSS - 1) * MAIN * 64 / 16; i += NGT) p2[i] = z;
      v4u* p2s = (v4u*)(F.ws + WS_SSPS + (size_t)256 * 256); for (size_t i = gt; i < (size_t)(NSS - 1) * 256 * 256 / 16; i += NGT) p2s[i] = z;
      v4u* p3 = (v4u*)(F.ws + WS_OB + (size_t)(SIDE + NSIDE) * D * 2); for (size_t i = gt; i < (size_t)(256 - NSIDE) * D * 2 / 16; i += NGT) p3[i] = z;
      v4u* p4 = (v4u*)(F.ws + WS_AO + (size_t)(SIDE + NSIDE) * D * 2); for (size_t i = gt; i < (size_t)(256 - NSIDE) * D * 2 / 16; i += NGT) p4[i] = z; }
    { bf16* HB = wsp<bf16>(F.ws, WS_HB); float* ss0m = wsp<float>(F.ws, WS_SSP); float* ss0s = wsp<float>(F.ws, WS_SSPS);
      for (int r0 = gw; r0 < M; r0 += 4 * NGW) {
        f32x4 v[4][4];
#pragma unroll
        for (int i = 0; i < 4; ++i) { const int r = r0 + i * NGW; const float* src = nullptr;
            if (r < MAIN) src = A.in[0] + (size_t)r * D; else if (r - SIDE < NMETA) src = A.in[6] + (size_t)(r - SIDE) * D; else if (r - SIDE < NSIDE) src = A.in[1] + (size_t)(r - SIDE - NMETA) * D;
#pragma unroll
            for (int j = 0; j < 4; ++j) { v[i][j] = (f32x4){0.f, 0.f, 0.f, 0.f}; if (src) v[i][j] = *(const f32x4*)(src + 256 * j + 4 * lane); } }
#pragma unroll
        for (int i = 0; i < 4; ++i) { const int r = r0 + i * NGW; float s = 0.f;
            if (r < M) {
#pragma unroll
                for (int j = 0; j < 4; ++j) { const f32x4 x = v[i][j]; v2u w; w.x = pk2(x[0], x[1]); w.y = pk2(x[2], x[3]); *(v2u*)(HB + (size_t)r * D + 256 * j + 4 * lane) = w;
                    s += (x[0] * x[0] + x[1] * x[1]) + (x[2] * x[2] + x[3] * x[3]); }
                s = wave_sum(s); if (r < SIDE) { if (lane < 16) ss0m[(size_t)r * 16 + lane] = lane == 0 ? s : 0.f; } else ss0s[(size_t)(r - SIDE) * 64 + lane] = lane == 0 ? s : 0.f; } }
      } }
    { float* rope = wsp<float>(F.ws, WS_ROPE);
      for (size_t i = gt; i < (size_t)ROPE_SLOTS * 32; i += NGT) { const int slot = (int)(i >> 5), k = (int)(i & 31); const float pos = slot < LPROMPT ? (float)slot : (float)PAST;
        const float invf = (float)exp2(-(double)k * (13.287712379549449 / 32.0));
        const float ang = pos * invf; const double a = (double)ang; const double n = rint(a * 0.6366197723675814); const double r = fma(-n, 1.5707963267948966, a) - n * 6.123233995736766e-17;
        const float rf = (float)r; float sn = __sinf(rf), cs = __cosf(rf); const int q = ((int)n) & 3;
        float c2 = (q == 0) ? cs : (q == 1) ? -sn : (q == 2) ? -cs : sn; float s2 = (q == 0) ? sn : (q == 1) ? cs : (q == 2) ? -sn : -cs;
        rope[2 * i] = c2; rope[2 * i + 1] = s2; }
      float* lbt = wsp<float>(F.ws, WS_LBT); const float* lbw = A.in[16];
      for (size_t i = gt; i < 1024; i += NGT) { const float x0 = lbw[i], x1 = lbw[1024 + i]; const float lb1 = 1.f / (1.f + expf(x0 - x1));
        lbt[i] = 0.f; lbt[1024 + i] = logf(1e-30f); lbt[2048 + i] = 1.f;
        lbt[3072 + i] = log1pf(-lb1); lbt[3072 + 1024 + i] = logf(fmaxf(lb1, 1e-30f)); lbt[3072 + 2048 + i] = 1.f - lb1; } }
}
namespace epi {
using pg8::Unit;
typedef const f32x4 (&AccRef)[2][2][4][2];
__device__ __forceinline__ void st_bf4(bf16* p, f32x4 v) { v2u w; w.x = pk2(v[0], v[1]); w.y = pk2(v[2], v[3]); *(v2u*)p = w; }
__device__ __forceinline__ void st_bf8(bf16* p, f32x4 a, f32x4 b) { v4u w; w.x = pk2(a[0], a[1]); w.y = pk2(a[2], a[3]); w.z = pk2(b[0], b[1]); w.w = pk2(b[2], b[3]); *(v4u*)p = w; }
__device__ __forceinline__ unsigned dpp_ror8u(unsigned x) { return (unsigned)__builtin_amdgcn_update_dpp(0, (int)x, 0x128, 0xf, 0xf, false); }
__device__ __forceinline__ void st_lines(bf16* p, size_t stride, v4u W0, v4u W1, int fr) {
    const bool lo = fr < 8; v4u send, recv;
    send.x = lo ? W1.x : W0.x; send.y = lo ? W1.y : W0.y; send.z = lo ? W1.z : W0.z; send.w = lo ? W1.w : W0.w;
    recv.x = dpp_ror8u(send.x); recv.y = dpp_ror8u(send.y); recv.z = dpp_ror8u(send.z); recv.w = dpp_ror8u(send.w);
    v4u first, second;
    first.x = lo ? W0.x : recv.x; first.y = lo ? W0.y : recv.y; first.z = lo ? W0.z : recv.z; first.w = lo ? W0.w : recv.w;
    second.x = lo ? recv.x : W1.x; second.y = lo ? recv.y : W1.y; second.z = lo ? recv.z : W1.z; second.w = lo ? recv.w : W1.w;
    bf16* p0 = lo ? p : p - 8 * stride + 8; bf16* p1 = lo ? p + 8 * stride : p + 8;
    *(v4u*)p0 = first; *(v4u*)p1 = second;
}
__device__ __forceinline__ v4u pk8(f32x4 a, f32x4 b) { v4u w; w.x = pk2(a[0], a[1]); w.y = pk2(a[2], a[3]); w.z = pk2(b[0], b[1]); w.w = pk2(b[2], b[3]); return w; }
__device__ __forceinline__ float silu(float x) { return x * __builtin_amdgcn_rcpf(1.f + __expf(-x)); }
__device__ __forceinline__ float sumsq(f32x4 v) { return (v[0] * v[0] + v[1] * v[1]) + (v[2] * v[2] + v[3] * v[3]); }
__device__ __forceinline__ void row_ss_put(const SSW s, int row, float q, int fq, int slot) {
    q = xg_sum(q);
    if (fq == 0) { if (row < SIDE) s.m[(size_t)row * 16 + slot] = q; else s.s[(size_t)(row - SIDE) * 64 + slot] = q; }
}
__device__ __forceinline__ f32x4 rope4(const float* rope, int row, int i, f32x4 x) {
    const f32x4 cs = *(const f32x4*)(rope + ((size_t)pos_slot(row) * 32 + i) * 2);
    f32x4 y; y[0] = x[0] * cs[0] - x[1] * cs[1]; y[1] = x[1] * cs[0] + x[0] * cs[1]; y[2] = x[2] * cs[2] - x[3] * cs[3]; y[3] = x[3] * cs[2] + x[2] * cs[3]; return y;
}
template <class E> struct Big {
    static constexpr bool PERM = true, AFTER_DRAIN = false; E e;
    __device__ __forceinline__ void operator()(AccRef acc, const Unit& u, int wr, int wc, int fr, int fq) const {
        const int cb = u.pn * 256, c16 = cb + wc * 64 + fq * 16;
#pragma unroll
        for (int ai = 0; ai < 2; ++ai) {
            float rs[4]; f32x4 pre[4][2][2];
#pragma unroll
            for (int m = 0; m < 4; ++m) { const int row = u.pm * 256 + ai * 128 + wr * 64 + m * 16 + fr; rs[m] = e.row_begin(row);
#pragma unroll
                for (int bj = 0; bj < 2; ++bj) e.load8(row, c16 + 8 * bj, pre[m][bj][0], pre[m][bj][1]); }
#pragma unroll
            for (int m = 0; m < 4; ++m) { const int row = u.pm * 256 + ai * 128 + wr * 64 + m * 16 + fr; float q = 0.f;
                if constexpr (E::LINES) q = e.apply16(row, c16, cb, acc[ai][0][m][0], acc[ai][0][m][1], acc[ai][1][m][0], acc[ai][1][m][1], rs[m], pre[m][0][0], pre[m][0][1], pre[m][1][0], pre[m][1][1], fr);
                else {
#pragma unroll
                    for (int bj = 0; bj < 2; ++bj) q += e.apply8(row, c16 + 8 * bj, cb, acc[ai][bj][m][0], acc[ai][bj][m][1], rs[m], pre[m][bj][0], pre[m][bj][1]); }
                e.row_end(row, q, fq, cb, u.pn * 4 + wc); }
            asm volatile("" ::: "memory");
        }
    }
};
struct HgIn {
    static constexpr bool LINES = true;
    SSR ss; bf16 *QB, *KB, *VB, *GB; float* LF; const float* lbt;
    __device__ __forceinline__ float row_begin(int row) const { return rstd_of(ss_get(ss, row), 1.f / D); }
    __device__ __forceinline__ f32x4 load(int, int) const { return (f32x4){0.f, 0.f, 0.f, 0.f}; }
    __device__ __forceinline__ float apply(int row, int col, int cb, f32x4 a, float rs, f32x4) const {
        const int kind = cb >> 10, c = col & (D - 1); const size_t o = (size_t)row * D + c; const f32x4 x = a * rs;
        if (kind == 0) { f32x4 y; y[0] = silu(x[0]); y[1] = silu(x[1]); y[2] = silu(x[2]); y[3] = silu(x[3]); st_bf4(QB + o, y); }
        else if (kind == 1) {
            const f32x4 L1 = *(const f32x4*)(lbt + c), L2 = *(const f32x4*)(lbt + D + c), OM = *(const f32x4*)(lbt + 2 * D + c);
            f32x4 lf, kk;
#pragma unroll
            for (int e = 0; e < 4; ++e) { const float z = x[e];
                const float ez = __expf(-fabsf(z)), r1 = __builtin_amdgcn_rcpf(1.f + ez);
                const float ls = fminf(z, 0.f) - __logf(1.f + ez);
                const float aa = L1[e] + ls, cc = L2[e], dd = fabsf(aa - cc);
                lf[e] = fmaxf(aa, cc) + (dd < 24.f ? __logf(1.f + __expf(-dd)) : 0.f);
                kk[e] = OM[e] * (z > 0.f ? ez : 1.f) * r1; }
            *(f32x4*)(LF + o) = lf; st_bf4(KB + o, kk); }
        else if (kind == 2) st_bf4(VB + o, x);
        else { f32x4 y; y[0] = silu(x[0]); y[1] = silu(x[1]); y[2] = silu(x[2]); y[3] = silu(x[3]); st_bf4(GB + o, y); }
        return 0.f;
    }
    __device__ __forceinline__ void load8(int, int, f32x4& p0, f32x4& p1) const { p0 = (f32x4){0.f, 0.f, 0.f, 0.f}; p1 = p0; }
    __device__ __forceinline__ float apply8(int row, int col, int cb, f32x4 a0, f32x4 a1, float rs, f32x4 p0, f32x4 p1) const {
        const int kind = cb >> 10, c = col & (D - 1); const size_t o = (size_t)row * D + c;
        if (kind == 1) { apply(row, col, cb, a0, rs, p0); apply(row, col + 4, cb, a1, rs, p1); return 0.f; }
        f32x4 x0 = a0 * rs, x1 = a1 * rs;
        if (kind != 2) {
#pragma unroll
            for (int e = 0; e < 4; ++e) { x0[e] = silu(x0[e]); x1[e] = silu(x1[e]); } }
        if (kind == 0) st_bf8(QB + o, x0, x1); else if (kind == 2) st_bf8(VB + o, x0, x1); else st_bf8(GB + o, x0, x1);
        return 0.f; }
    __device__ __forceinline__ float apply16(int row, int col, int cb, f32x4 a0, f32x4 a1, f32x4 a2, f32x4 a3, float rs, f32x4 p0, f32x4 p1, f32x4 p2, f32x4 p3, int fr) const {
        const int kind = cb >> 10, c = col & (D - 1); const size_t o = (size_t)row * D + c;
        if (kind == 1) { apply(row, col, cb, a0, rs, p0); apply(row, col + 4, cb, a1, rs, p1); apply(row, col + 8, cb, a2, rs, p2); apply(row, col + 12, cb, a3, rs, p3); return 0.f; }
        f32x4 x0 = a0 * rs, x1 = a1 * rs, x2 = a2 * rs, x3 = a3 * rs;
        if (kind != 2) {
#pragma unroll
            for (int e = 0; e < 4; ++e) { x0[e] = silu(x0[e]); x1[e] = silu(x1[e]); x2[e] = silu(x2[e]); x3[e] = silu(x3[e]); } }
        const v4u W0 = pk8(x0, x1), W1 = pk8(x2, x3);
        if (kind == 0) st_lines(QB + o, D, W0, W1, fr); else if (kind == 2) st_lines(VB + o, D, W0, W1, fr); else st_lines(GB + o, D, W0, W1, fr);
        return 0.f; }
    __device__ __forceinline__ void row_end(int, float, int, int, int) const {}
};
template <bool FIRST> struct ResT {
    static constexpr bool LINES = true;
    const float* Xin; bf16* HB; SSW ssn; int dry; const float* meta; const float* xs;
    __device__ __forceinline__ float row_begin(int) const { return 1.f; }
    __device__ __forceinline__ f32x4 load(int row, int col) const {
        if constexpr (FIRST) { const float* src = Xin + (size_t)row * D + col;
            if (row >= SIDE) src = (row - SIDE < NMETA ? meta + (size_t)(row - SIDE) * D : xs + (size_t)(row - SIDE - NMETA) * D) + col;
            return *(const f32x4*)src; }
        else { const v2u w = *(const v2u*)(HB + (size_t)row * D + col); return (f32x4){bflo(w.x), bfhi(w.x), bflo(w.y), bfhi(w.y)}; } }
    __device__ __forceinline__ float apply(int row, int col, int, f32x4 a, float, f32x4 pre) const { const size_t o = (size_t)row * D + col;
        const f32x4 h = pre + a; if (!dry) st_bf4(HB + o, h); return sumsq(h); }
    __device__ __forceinline__ void load8(int row, int col, f32x4& p0, f32x4& p1) const {
        if constexpr (FIRST) { p0 = load(row, col); p1 = load(row, col + 4); }
        else { const v4u w = *(const v4u*)(HB + (size_t)row * D + col); p0 = (f32x4){bflo(w.x), bfhi(w.x), bflo(w.y), bfhi(w.y)}; p1 = (f32x4){bflo(w.z), bfhi(w.z), bflo(w.w), bfhi(w.w)}; } }
    __device__ __forceinline__ float apply8(int row, int col, int, f32x4 a0, f32x4 a1, float, f32x4 p0, f32x4 p1) const { const f32x4 h0 = p0 + a0, h1 = p1 + a1;
        if (!dry) st_bf8(HB + (size_t)row * D + col, h0, h1); return sumsq(h0) + sumsq(h1); }
    __device__ __forceinline__ float apply16(int row, int col, int, f32x4 a0, f32x4 a1, f32x4 a2, f32x4 a3, float, f32x4 p0, f32x4 p1, f32x4 p2, f32x4 p3, int fr) const {
        const f32x4 h0 = p0 + a0, h1 = p1 + a1, h2 = p2 + a2, h3 = p3 + a3;
        if (!dry) st_lines(HB + (size_t)row * D + col, D, pk8(h0, h1), pk8(h2, h3), fr);
        return (sumsq(h0) + sumsq(h1)) + (sumsq(h2) + sumsq(h3)); }
    __device__ __forceinline__ void row_end(int row, float q, int fq, int, int slot) const { if (!dry) row_ss_put(ssn, row, q, fq, slot); }
};
struct Up {
    static constexpr bool LINES = true;
    SSR ss; bf16* HID;
    __device__ __forceinline__ float row_begin(int row) const { return rstd_of(ss_get(ss, row), 1.f / D); }
    __device__ __forceinline__ f32x4 load(int, int) const { return (f32x4){0.f, 0.f, 0.f, 0.f}; }
    __device__ __forceinline__ float apply(int row, int col, int, f32x4 a, float rs, f32x4) const { f32x4 x = a * rs;
#pragma unroll
        for (int e = 0; e < 4; ++e) { const float r = fmaxf(x[e], 0.f); x[e] = r * r; }
        st_bf4(HID + (size_t)row * FF + col, x); return 0.f; }
    __device__ __forceinline__ void load8(int, int, f32x4& p0, f32x4& p1) const { p0 = (f32x4){0.f, 0.f, 0.f, 0.f}; p1 = p0; }
    __device__ __forceinline__ float apply8(int row, int col, int, f32x4 a0, f32x4 a1, float rs, f32x4, f32x4) const { f32x4 x0 = a0 * rs, x1 = a1 * rs;
#pragma unroll
        for (int e = 0; e < 4; ++e) { const float r0 = fmaxf(x0[e], 0.f), r1 = fmaxf(x1[e], 0.f); x0[e] = r0 * r0; x1[e] = r1 * r1; }
        st_bf8(HID + (size_t)row * FF + col, x0, x1); return 0.f; }
    __device__ __forceinline__ float apply16(int row, int col, int, f32x4 a0, f32x4 a1, f32x4 a2, f32x4 a3, float rs, f32x4, f32x4, f32x4, f32x4, int fr) const {
        f32x4 x0 = a0 * rs, x1 = a1 * rs, x2 = a2 * rs, x3 = a3 * rs;
#pragma unroll
        for (int e = 0; e < 4; ++e) { const float r0 = fmaxf(x0[e], 0.f), r1 = fmaxf(x1[e], 0.f), r2 = fmaxf(x2[e], 0.f), r3 = fmaxf(x3[e], 0.f); x0[e] = r0 * r0; x1[e] = r1 * r1; x2[e] = r2 * r2; x3[e] = r3 * r3; }
        st_lines(HID + (size_t)row * FF + col, FF, pk8(x0, x1), pk8(x2, x3), fr); return 0.f; }
    __device__ __forceinline__ void row_end(int, float, int, int, int) const {}
};
struct KvQ {
    static constexpr bool LINES = false;
    SSR ss; float* CKVF; bf16* CKVB; float* KRF; bf16* KRB; bf16* CQB; SSW ss_ckv; SSW ss_cq; const float* rope;
    __device__ __forceinline__ float row_begin(int row) const { return rstd_of(ss_get(ss, row), 1.f / D); }
    __device__ __forceinline__ f32x4 load(int, int) const { return (f32x4){0.f, 0.f, 0.f, 0.f}; }
    __device__ __forceinline__ float apply(int row, int col, int, f32x4 a, float rs, f32x4) const {
        const f32x4 x = a * rs;
        if (col < KVL) { *(f32x4*)(CKVF + (size_t)row * KVL + col) = x; st_bf4(CKVB + (size_t)row * KVL + col, x); return sumsq(x); }
        if (col < KVL + ROPE) { const int jj = col - KVL, i = jj >> 1; const f32x4 y = rope4(rope, row, i, x);
            float* kf = KRF + (size_t)row * ROPE; kf[i] = y[0]; kf[32 + i] = y[1]; kf[i + 1] = y[2]; kf[33 + i] = y[3];
            st_bf4(KRB + (size_t)row * ROPE + jj, y); return 0.f; }
        if (col < KVL + ROPE + QL) { st_bf4(CQB + (size_t)row * QL + (col - KVL - ROPE), x); return sumsq(x); }
        return 0.f;
    }
    __device__ __forceinline__ void load8(int, int, f32x4& p0, f32x4& p1) const { p0 = (f32x4){0.f, 0.f, 0.f, 0.f}; p1 = p0; }
    __device__ __forceinline__ float apply8(int row, int col, int cb, f32x4 a0, f32x4 a1, float rs, f32x4 p0, f32x4 p1) const {
        if (col >= KVL + ROPE && col < KVL + ROPE + QL) { const f32x4 x0 = a0 * rs, x1 = a1 * rs; st_bf8(CQB + (size_t)row * QL + (col - KVL - ROPE), x0, x1); return sumsq(x0) + sumsq(x1); }
        return apply(row, col, cb, a0, rs, p0) + apply(row, col + 4, cb, a1, rs, p1); }
    __device__ __forceinline__ void row_end(int row, float q, int fq, int cb, int slot) const { if (cb < KVL) row_ss_put(ss_ckv, row, q, fq, row < SIDE ? (slot & 3) : slot); else row_ss_put(ss_cq, row, q, fq, row < SIDE ? slot - 4 : slot); }
};
struct Dq {
    static constexpr bool LINES = false;
    SSR ss; bf16* CQB; SSW ss_cq;
    __device__ __forceinline__ float row_begin(int row) const { return rstd_of(ss_get(ss, row), 1.f / D); }
    __device__ __forceinline__ f32x4 load(int, int) const { return (f32x4){0.f, 0.f, 0.f, 0.f}; }
    __device__ __forceinline__ float apply(int row, int col, int, f32x4 a, float rs, f32x4) const { const f32x4 x = a * rs; if (col < QL) { st_bf4(CQB + (size_t)row * QL + col, x); return sumsq(x); } return 0.f; }
    __device__ __forceinline__ void load8(int, int, f32x4& p0, f32x4& p1) const { p0 = (f32x4){0.f, 0.f, 0.f, 0.f}; p1 = p0; }
    __device__ __forceinline__ float apply8(int row, int col, int, f32x4 a0, f32x4 a1, float rs, f32x4, f32x4) const { const f32x4 x0 = a0 * rs, x1 = a1 * rs; if (col < QL) { st_bf8(CQB + (size_t)row * QL + col, x0, x1); return sumsq(x0) + sumsq(x1); } return 0.f; }
    __device__ __forceinline__ void row_end(int row, float q, int fq, int, int slot) const { row_ss_put(ss_cq, row, q, fq, slot); }
};
struct Uq {
    static constexpr bool LINES = false;
    SSR ss_cq; bf16* QN; bf16* QR; const float* rope;
    __device__ __forceinline__ float row_begin(int row) const { return rstd_of(ss_get(ss_cq, row), 1.f / QL); }
    __device__ __forceinline__ f32x4 load(int, int) const { return (f32x4){0.f, 0.f, 0.f, 0.f}; }
    __device__ __forceinline__ float apply(int row, int col, int cb, f32x4 a, float rs, f32x4) const {
        const f32x4 x = a * rs;
        if (cb < D) st_bf4(QN + (size_t)row * D + col, x);
        else { const int cc = col - D; st_bf4(QR + (size_t)row * 512 + cc, rope4(rope, row, (cc & 63) >> 1, x)); }
        return 0.f;
    }
    __device__ __forceinline__ void load8(int, int, f32x4& p0, f32x4& p1) const { p0 = (f32x4){0.f, 0.f, 0.f, 0.f}; p1 = p0; }
    __device__ __forceinline__ float apply8(int row, int col, int cb, f32x4 a0, f32x4 a1, float rs, f32x4, f32x4) const {
        const f32x4 x0 = a0 * rs, x1 = a1 * rs;
        if (cb < D) st_bf8(QN + (size_t)row * D + col, x0, x1);
        else { const int cc = col - D; st_bf8(QR + (size_t)row * 512 + cc, rope4(rope, row, (cc & 63) >> 1, x0), rope4(rope, row, ((cc + 4) & 63) >> 1, x1)); }
        return 0.f; }
    __device__ __forceinline__ void row_end(int, float, int, int, int) const {}
};
struct KvUp {
    static constexpr bool LINES = false;
    SSR ss_ckv; bf16* KN; bf16* VV;
    __device__ __forceinline__ float row_begin(int row) const { return rstd_of(ss_get(ss_ckv, row), 1.f / KVL); }
    __device__ __forceinline__ f32x4 load(int, int) const { return (f32x4){0.f, 0.f, 0.f, 0.f}; }
    __device__ __forceinline__ float apply(int row, int col, int cb, f32x4 a, float rs, f32x4) const { const f32x4 x = a * rs; if (cb < D) st_bf4(KN + (size_t)row * D + col, x); else st_bf4(VV + (size_t)row * D + (col - D), x); return 0.f; }
    __device__ __forceinline__ void load8(int, int, f32x4& p0, f32x4& p1) const { p0 = (f32x4){0.f, 0.f, 0.f, 0.f}; p1 = p0; }
    __device__ __forceinline__ float apply8(int row, int col, int cb, f32x4 a0, f32x4 a1, float rs, f32x4, f32x4) const { const f32x4 x0 = a0 * rs, x1 = a1 * rs; if (cb < D) st_bf8(KN + (size_t)row * D + col, x0, x1); else st_bf8(VV + (size_t)row * D + (col - D), x0, x1); return 0.f; }
    __device__ __forceinline__ void row_end(int, float, int, int, int) const {}
};

constexpr int SIDE_MT = NSIDE / 16;
template <class E> __device__ __forceinline__ void side_gemm(const Frame& F, const bf16* __restrict__ A, const bf16* __restrict__ Bt, int N, int K, const E& e) {
    const int tid = F.wave * 64 + lane_id_v(), w = __builtin_amdgcn_readfirstlane(tid >> 6), lane = tid & 63, g = lane >> 4, li = lane & 15;
    LAS f32x4* red = (LAS f32x4*)F.lds;
    const int nks = K / 32, ncg = N / 16;
    int nrp = (F.G * 16) / N; nrp = nrp < 1 ? 1 : (nrp > SIDE_MT ? SIDE_MT : nrp);
    for (int it = F.bid; it < ncg * nrp; it += F.G) {
        const int cg = it / nrp, rp = it - cg * nrp, m0 = (rp * SIDE_MT) / nrp, m1 = ((rp + 1) * SIDE_MT) / nrp;
        f32x4 acc[SIDE_MT];
#pragma unroll
        for (int mt = 0; mt < SIDE_MT; ++mt) acc[mt] = (f32x4){0.f, 0.f, 0.f, 0.f};
        const bf16* bp = Bt + (size_t)(cg * 16 + li) * K + 8 * g; const bf16* ap = A + (size_t)(SIDE + li) * K + 8 * g;
#pragma unroll 2
        for (int ks = w; ks < nks; ks += 8) {
            const bf16x8 bfr = *(const bf16x8*)(bp + 32 * ks); bf16x8 afr[SIDE_MT];
#pragma unroll
            for (int mt = 0; mt < SIDE_MT; ++mt) if (mt >= m0 && mt < m1) afr[mt] = *(const bf16x8*)(ap + (size_t)(16 * mt) * K + 32 * ks);
#pragma unroll
            for (int mt = 0; mt < SIDE_MT; ++mt) if (mt >= m0 && mt < m1) acc[mt] = mfma16(bfr, afr[mt], acc[mt]);
        }
#pragma unroll
        for (int mt = 0; mt < SIDE_MT; ++mt) if (mt >= m0 && mt < m1) red[(w * SIDE_MT + mt) * 64 + lane] = acc[mt];
        __syncthreads();
#pragma unroll 1
        for (int mt = m0 + w; mt < m1; mt += 8) {
            f32x4 s = red[mt * 64 + lane];
#pragma unroll
            for (int ww = 1; ww < 8; ++ww) s += red[(ww * SIDE_MT + mt) * 64 + lane];
            const int row = SIDE + 16 * mt + li, cb = cg * 16; const float rs = e.row_begin(row);
            const float q = e.apply(row, cb + 4 * g, cb, s, rs, e.load(row, cb + 4 * g)); e.row_end(row, q, g, cb, cg);
        }
        __syncthreads();
    }
}
}
constexpr int HG_RS = 288;
constexpr int HG_QT = 0, HG_KT = 32 * HG_RS, HG_VT = 2 * 32 * HG_RS, HG_GT = 3 * 32 * HG_RS, HG_OT = 4 * 32 * HG_RS, HG_EC = 5 * 32 * HG_RS, HG_WTOT = HG_EC + 512, HG_SSX = HG_WTOT + 8 * 128 * 4, HG_END = HG_SSX + 32 * 8 * 4;
#define HG_BAR() do { asm volatile("s_waitcnt lgkmcnt(0)" ::: "memory"); __builtin_amdgcn_s_barrier(); asm volatile("" ::: "memory"); } while (0)
struct HgRegs { v4u q, k, v, gt; f32x4 l0, l1; };
struct HgCtx { const bf16 *QB, *KB, *VB, *GB; const float* LF; bf16* OB; LAS unsigned char* lds; int tid, w, lane, g, li, st, skg, b, h; };
__device__ __forceinline__ int hg_row(const HgCtx& C, int c, int t) { return c == 0 ? SIDE + t : C.b * T + 32 * (c - 1) + t; }
__device__ __forceinline__ bool hg_live(const HgCtx& C, int c, int t) { return c > 0 ? true : (t < NMETA); }
__device__ __forceinline__ void hg_load(const HgCtx& C, HgRegs& R, int c) {
    const int tk = C.lane & 31; const size_t o = (size_t)hg_row(C, c, tk) * D + C.h * HK + 16 * C.w + 8 * (C.lane >> 5);
    R.q = (v4u){0u, 0u, 0u, 0u}; R.k = R.q; R.v = R.q; R.gt = R.q; R.l0 = (f32x4){0.f, 0.f, 0.f, 0.f}; R.l1 = R.l0;
    if (hg_live(C, c, tk)) { R.q = *(const v4u*)(C.QB + o); R.k = *(const v4u*)(C.KB + o); R.v = *(const v4u*)(C.VB + o); R.gt = *(const v4u*)(C.GB + o); R.l0 = *(const f32x4*)(C.LF + o); R.l1 = *(const f32x4*)(C.LF + o + 4); }
}
template <int CTRL, int RMASK> __device__ __forceinline__ float dpp_mv(float x) { return __builtin_bit_cast(float, __builtin_amdgcn_update_dpp(0, __builtin_bit_cast(int, x), CTRL, RMASK, 0xf, false)); }
__device__ __forceinline__ float scan32(float x) {
    x += dpp_mv<0x111, 0xf>(x); x += dpp_mv<0x112, 0xf>(x); x += dpp_mv<0x114, 0xf>(x); x += dpp_mv<0x118, 0xf>(x);
    x += dpp_mv<0x142, 0xa>(x); return x;
}
__device__ __forceinline__ void hg_store_out(const HgCtx& C, int c) {
    if (hg_live(C, c, C.st) && (c > 0 || C.b == 0)) *(v4u*)(C.OB + (size_t)hg_row(C, c, C.st) * D + C.h * HV + 8 * C.skg) = *(const LAS v4u*)(C.lds + HG_OT + C.st * HG_RS + C.skg * 16);
}
__device__ __forceinline__ void hg_chunk(const HgCtx& C, HgRegs& R, f32x4 (&S)[8], int c, int nch) {
    LAS unsigned char* Qt = C.lds + HG_QT; LAS unsigned char* Kt = C.lds + HG_KT; LAS unsigned char* Vt = C.lds + HG_VT; LAS unsigned char* Gt = C.lds + HG_GT; LAS unsigned char* Ot = C.lds + HG_OT;
    LAS float* eC = (LAS float*)(C.lds + HG_EC); LAS float* ssx = (LAS float*)(C.lds + HG_SSX);
    const int w = C.w, lane = C.lane, g = C.g, li = C.li;
    float x[8] = {R.l0[0], R.l0[1], R.l0[2], R.l0[3], R.l1[0], R.l1[1], R.l1[2], R.l1[3]};
#pragma unroll
    for (int e = 0; e < 8; ++e) x[e] = scan32(x[e]);
    HG_BAR();
    if (c > 0) hg_store_out(C, c - 1);
    { const int tk = lane & 31, cb = 16 * w + 8 * (lane >> 5);
      const unsigned qw[4] = {R.q.x, R.q.y, R.q.z, R.q.w}, kw[4] = {R.k.x, R.k.y, R.k.z, R.k.w}; unsigned oq[4], ok[4];
#pragma unroll
      for (int e = 0; e < 4; ++e) { const float e0 = __expf(x[2 * e]), e1 = __expf(x[2 * e + 1]), i0 = __expf(fminf(-x[2 * e], 80.f)), i1 = __expf(fminf(-x[2 * e + 1], 80.f));
          oq[e] = pk2(bflo(qw[e]) * e0, bfhi(qw[e]) * e1); ok[e] = pk2(bflo(kw[e]) * i0, bfhi(kw[e]) * i1);
          if (tk == 31) { eC[cb + 2 * e] = e0; eC[cb + 2 * e + 1] = e1; } }
      *(LAS v4u*)(Qt + tk * HG_RS + cb * 2) = (v4u){oq[0], oq[1], oq[2], oq[3]}; *(LAS v4u*)(Kt + tk * HG_RS + cb * 2) = (v4u){ok[0], ok[1], ok[2], ok[3]};
      *(LAS v4u*)(Vt + tk * HG_RS + cb * 2) = R.v; *(LAS v4u*)(Gt + tk * HG_RS + cb * 2) = R.gt; }
    HG_BAR();
    if (c + 2 < nch) hg_load(C, R, c + 2);
    const unsigned kr_ = (unsigned)(size_t)(Kt + li * HG_RS + 16 * g), qr_ = (unsigned)(size_t)(Qt + li * HG_RS + 16 * g), qa_ = (unsigned)(size_t)(Qt + li * HG_RS + 8 * g);
    const unsigned vp_ = (unsigned)(size_t)(Vt + (4 * g + (li >> 2)) * HG_RS + (16 * w + 4 * (li & 3)) * 2), kp_ = (unsigned)(size_t)(Kt + (4 * g + (li >> 2)) * HG_RS + (4 * (li & 3)) * 2);
    const unsigned ec_ = (unsigned)(size_t)((LAS unsigned char*)eC + 16 * g);
    bf16x8 k0[4], k1[4], q0[4], q1[4]; s16x4 vlo, vhi, al[4][2], ah[4][2], klo[8], khi[8]; f32x4 ecv[8];
#pragma unroll
    for (int ks = 0; ks < 4; ++ks) {
        asm volatile("ds_read_b128 %0, %1 offset:%2" : "=v"(k0[ks]) : "v"(kr_), "i"(64 * ks));
        asm volatile("ds_read_b128 %0, %1 offset:%2" : "=v"(k1[ks]) : "v"(kr_), "i"(16 * HG_RS + 64 * ks));
        asm volatile("ds_read_b128 %0, %1 offset:%2" : "=v"(q0[ks]) : "v"(qr_), "i"(64 * ks));
        asm volatile("ds_read_b128 %0, %1 offset:%2" : "=v"(q1[ks]) : "v"(qr_), "i"(16 * HG_RS + 64 * ks)); }
    asm volatile("ds_read_b64_tr_b16 %0, %1 offset:%2" : "=v"(vlo) : "v"(vp_), "i"(0));
    asm volatile("ds_read_b64_tr_b16 %0, %1 offset:%2" : "=v"(vhi) : "v"(vp_), "i"(16 * HG_RS));
#pragma unroll
    for (int ks = 0; ks < 4; ++ks) {
        asm volatile("ds_read_b64 %0, %1 offset:%2" : "=v"(al[ks][0]) : "v"(qa_), "i"(64 * ks));
        asm volatile("ds_read_b64 %0, %1 offset:%2" : "=v"(al[ks][1]) : "v"(qa_), "i"(64 * ks + 32));
        asm volatile("ds_read_b64 %0, %1 offset:%2" : "=v"(ah[ks][0]) : "v"(qa_), "i"(16 * HG_RS + 64 * ks));
        asm volatile("ds_read_b64 %0, %1 offset:%2" : "=v"(ah[ks][1]) : "v"(qa_), "i"(16 * HG_RS + 64 * ks + 32)); }
    asm volatile("s_waitcnt lgkmcnt(15)" : "+v"(k0[0]), "+v"(k0[1]), "+v"(k0[2]), "+v"(k0[3]), "+v"(k1[0]), "+v"(k1[1]), "+v"(k1[2]), "+v"(k1[3]), "+v"(q0[0]), "+v"(q0[1]), "+v"(q0[2]), "+v"(q0[3]), "+v"(q1[0]), "+v"(q1[1]), "+v"(q1[2]), "+v"(q1[3]), "+v"(vlo), "+v"(vhi));
    f32x4 d00 = {0.f, 0.f, 0.f, 0.f}, d01 = d00, d11 = d00;
#pragma unroll
    for (int ks = 0; ks < 4; ++ks) { d00 = mfma16(k0[ks], q0[ks], d00); d01 = mfma16(k0[ks], q1[ks], d01); d11 = mfma16(k1[ks], q1[ks], d11); }
#pragma unroll
    for (int r = 0; r < 4; ++r) { if (4 * g + r > li) { d00[r] = 0.f; d11[r] = 0.f; } }
    const bf16x8 p0 = pack8(d00, (f32x4){0.f, 0.f, 0.f, 0.f}), p1 = pack8(d01, d11);
    const bf16x8 vf = cat4(vlo, vhi);
    f32x4 o0 = mfma16(p0, vf, (f32x4){0.f, 0.f, 0.f, 0.f}), o1 = mfma16(p1, vf, (f32x4){0.f, 0.f, 0.f, 0.f});
    asm volatile("s_waitcnt lgkmcnt(0)" : "+v"(al[0][0]), "+v"(al[0][1]), "+v"(al[1][0]), "+v"(al[1][1]), "+v"(al[2][0]), "+v"(al[2][1]), "+v"(al[3][0]), "+v"(al[3][1]), "+v"(ah[0][0]), "+v"(ah[0][1]), "+v"(ah[1][0]), "+v"(ah[1][1]), "+v"(ah[2][0]), "+v"(ah[2][1]), "+v"(ah[3][0]), "+v"(ah[3][1]));
#define HG_RD3(kb_) do { asm volatile("ds_read_b64_tr_b16 %0, %1 offset:%2" : "=v"(klo[kb_]) : "v"(kp_), "i"(32 * (kb_))); \
        asm volatile("ds_read_b64_tr_b16 %0, %1 offset:%2" : "=v"(khi[kb_]) : "v"(kp_), "i"(16 * HG_RS + 32 * (kb_))); \
        asm volatile("ds_read_b128 %0, %1 offset:%2" : "=v"(ecv[kb_]) : "v"(ec_), "i"(64 * (kb_))); } while (0)
    HG_RD3(0); HG_RD3(1); HG_RD3(2); HG_RD3(3);
#pragma unroll
    for (int ks = 0; ks < 4; ++ks) {
        const bf16x8 sb = pack8(S[2 * ks], S[2 * ks + 1]);
        o0 = mfma16(cat4(al[ks][0], al[ks][1]), sb, o0); o1 = mfma16(cat4(ah[ks][0], ah[ks][1]), sb, o1);
    }
    HG_RD3(4); HG_RD3(5); HG_RD3(6); HG_RD3(7);
#undef HG_RD3
    asm volatile("s_waitcnt lgkmcnt(12)" : "+v"(klo[0]), "+v"(klo[1]), "+v"(klo[2]), "+v"(klo[3]), "+v"(khi[0]), "+v"(khi[1]), "+v"(khi[2]), "+v"(khi[3]), "+v"(ecv[0]), "+v"(ecv[1]), "+v"(ecv[2]), "+v"(ecv[3]));
#pragma unroll
    for (int kb = 0; kb < 4; ++kb) S[kb] = mfma16(cat4(klo[kb], khi[kb]), vf, S[kb]) * ecv[kb];
    asm volatile("s_waitcnt lgkmcnt(0)" : "+v"(klo[4]), "+v"(klo[5]), "+v"(klo[6]), "+v"(klo[7]), "+v"(khi[4]), "+v"(khi[5]), "+v"(khi[6]), "+v"(khi[7]), "+v"(ecv[4]), "+v"(ecv[5]), "+v"(ecv[6]), "+v"(ecv[7]));
#pragma unroll
    for (int kb = 4; kb < 8; ++kb) S[kb] = mfma16(cat4(klo[kb], khi[kb]), vf, S[kb]) * ecv[kb];
    float q2[8];
#pragma unroll
    for (int r = 0; r < 4; ++r) { q2[r] = o0[r] * o0[r]; q2[4 + r] = o1[r] * o1[r]; }
#pragma unroll
    for (int e = 0; e < 8; ++e) q2[e] = row_sum16(q2[e]);
    if (li == 0) {
#pragma unroll
        for (int r = 0; r < 4; ++r) { ssx[(4 * g + r) * 8 + w] = q2[r]; ssx[(16 + 4 * g + r) * 8 + w] = q2[4 + r]; } }
    HG_BAR();
#pragma unroll
    for (int tb = 0; tb < 2; ++tb)
#pragma unroll
        for (int r = 0; r < 4; ++r) { const int t = 16 * tb + 4 * g + r; const f32x4 s0 = *(const LAS f32x4*)(ssx + t * 8), s1 = *(const LAS f32x4*)(ssx + t * 8 + 4);
            const float rs = rstd_of((s0[0] + s0[1]) + (s0[2] + s0[3]) + (s1[0] + s1[1]) + (s1[2] + s1[3]), 1.f / HV);
            const float gv = bf2f(*(const LAS bf16*)(Gt + t * HG_RS + (16 * w + li) * 2));
            *(LAS bf16*)(Ot + t * HG_RS + (16 * w + li) * 2) = (bf16)f2bf((tb == 0 ? o0[r] : o1[r]) * rs * gv); }
}
__device__ __forceinline__ void hg_prompt_unit(const Frame& F, int l, int u) {
    HgCtx C; C.tid = F.wave * 64 + lane_id_v(); C.w = __builtin_amdgcn_readfirstlane(C.tid >> 6); C.lane = C.tid & 63; C.g = C.lane >> 4; C.li = C.lane & 15; C.st = C.tid >> 4; C.skg = C.tid & 15;
    C.b = u >> 3; C.h = u & 7; C.lds = F.lds;
    C.QB = wsp<bf16>(F.ws, WS_QB); C.KB = wsp<bf16>(F.ws, WS_KB); C.VB = wsp<bf16>(F.ws, WS_VB); C.GB = wsp<bf16>(F.ws, WS_GB); C.LF = wsp<float>(F.ws, WS_LF); C.OB = wsp<bf16>(F.ws, WS_OB);
    f32x4 S[8];
#pragma unroll
    for (int kb = 0; kb < 8; ++kb) S[kb] = (f32x4){0.f, 0.f, 0.f, 0.f};
    constexpr int NCH = 1 + T / 32;
    HgRegs RA, RB; hg_load(C, RA, 0); hg_load(C, RB, 1);
#pragma unroll 1
    for (int c = 0; c < NCH; c += 2) { hg_chunk(C, RA, S, c, NCH); if (c + 1 < NCH) hg_chunk(C, RB, S, c + 1, NCH); }
    HG_BAR();
    hg_store_out(C, NCH - 1);
    float* so = F.out + O_SP + ((size_t)(l * NB + C.b) * HH + C.h) * HK * HV;
#pragma unroll
    for (int kb = 0; kb < 8; ++kb)
#pragma unroll
        for (int r = 0; r < 4; ++r) so[(size_t)(16 * kb + 4 * C.g + r) * HV + 16 * C.w + C.li] = S[kb][r];
    __syncthreads();
}
__device__ __forceinline__ void hg_sample_unit(const Frame& F, const float* state_in, int l, int u) {
    int tid_ = F.wave * 64 + lane_id_v(); const int tid = tid_, w = __builtin_amdgcn_readfirstlane(tid >> 6), lane = tid & 63, hw = lane >> 5, l32 = lane & 31;
    const int bs = u >> 3, h = u & 7; const int row = SIDE + NMETA + bs;
    const bf16* QB = wsp<bf16>(F.ws, WS_QB); const bf16* KB = wsp<bf16>(F.ws, WS_KB); const bf16* VB = wsp<bf16>(F.ws, WS_VB); const bf16* GB = wsp<bf16>(F.ws, WS_GB);
    const float* LF = wsp<float>(F.ws, WS_LF); bf16* OB = wsp<bf16>(F.ws, WS_OB);
    LAS float* part = (LAS float*)F.lds;
    const size_t so = ((size_t)(l * NS + bs) * HH + h) * HK * HV; const float* s0 = state_in + so; float* s1 = F.out + O_SS + so;
    const size_t ro = (size_t)row * D + h * HK;
    const v2u vv = *(const v2u*)(VB + ro + 4 * l32); const f32x4 v4 = {bflo(vv.x), bfhi(vv.x), bflo(vv.y), bfhi(vv.y)};
    f32x4 st[8]; float fv[8], kv[8], qv[8];
#pragma unroll
    for (int i = 0; i < 8; ++i) { const int k = 16 * w + 2 * i + hw; st[i] = *(const f32x4*)(s0 + (size_t)k * HV + 4 * l32); fv[i] = LF[ro + k]; kv[i] = bf2f(KB[ro + k]); qv[i] = bf2f(QB[ro + k]); }
    f32x4 o = {0.f, 0.f, 0.f, 0.f};
#pragma unroll
    for (int i = 0; i < 8; ++i) { const int k = 16 * w + 2 * i + hw; const f32x4 a = st[i] * __expf(fv[i]) + v4 * kv[i]; *(f32x4*)(s1 + (size_t)k * HV + 4 * l32) = a; o += a * qv[i]; }
#pragma unroll
    for (int e = 0; e < 4; ++e) o[e] = half_sum(o[e]);
    if (hw == 0) *(LAS f32x4*)(part + w * 128 + 4 * l32) = o;
    HG_BAR();
    float s = 0.f;
    if (tid < 128) {
#pragma unroll
        for (int ww = 0; ww < 8; ++ww) s += part[ww * 128 + tid];
        const float q = wave_sum(s * s); if (lane == 0) part[1024 + w] = q; }
    HG_BAR();
    if (tid < 128) { const float rs = rstd_of(part[1024] + part[1025], 1.f / HV); OB[ro + tid] = (bf16)f2bf(s * rs * bf2f(GB[ro + tid])); }
    HG_BAR();
}
__device__ __forceinline__ void kv_outputs(const Frame& F, const float* kv_gain) {
    const float* CKVF = wsp<float>(F.ws, WS_CKVF); const float* KRF = wsp<float>(F.ws, WS_KRF); const SSR ssc{wsp<float>(F.ws, WS_SSP) + (size_t)SS_CKV * MAIN * 16, wsp<float>(F.ws, WS_SSPS) + (size_t)SS_CKV * 256 * 64};
    int tid_ = F.wave * 64 + lane_id_v(); const int lane = tid_ & 63, gw = F.bid * 8 + __builtin_amdgcn_readfirstlane(tid_ >> 6), NGW = F.G * 8; const f32x4 g4 = *(const f32x4*)(kv_gain + 4 * lane);
    for (int i = gw; i < NB * LPROMPT + NS; i += NGW) {
        int src; float* oc; float* ok;
        if (i < NB * LPROMPT) { const int b = i / LPROMPT, p = i - b * LPROMPT; src = p < NMETA ? SIDE + p : b * T + p - NMETA; oc = F.out + O_CKVP + (size_t)i * KVL; ok = F.out + O_KRP + (size_t)i * ROPE; }
        else { const int bs = i - NB * LPROMPT; src = SIDE + NMETA + bs; oc = F.out + O_CKVS + (size_t)bs * KVL; ok = F.out + O_KRS + (size_t)bs * ROPE; }
        const float rs = rstd_of(ss_get(ssc, src), 1.f / KVL); const f32x4 x = *(const f32x4*)(CKVF + (size_t)src * KVL + 4 * lane);
        *(f32x4*)(oc + 4 * lane) = x * rs * g4; ok[lane] = KRF[(size_t)src * ROPE + lane];
    }
}
__device__ __forceinline__ void final_norm(const Frame& F, const float* gain) {
    const bf16* HB = wsp<bf16>(F.ws, WS_HB); const SSR ss{wsp<float>(F.ws, WS_SSP) + (size_t)8 * MAIN * 16, wsp<float>(F.ws, WS_SSPS) + (size_t)8 * 256 * 64};
    int tid_ = F.wave * 64 + lane_id_v(); const int lane = tid_ & 63, gw = F.bid * 8 + __builtin_amdgcn_readfirstlane(tid_ >> 6), NGW = F.G * 8;
    for (int i = gw; i < MAIN + NS; i += NGW) {
        const int r = i < MAIN ? i : SIDE + NMETA + (i - MAIN); float* o = i < MAIN ? F.out + O_Y + (size_t)i * D : F.out + O_YS + (size_t)(i - MAIN) * D;
        const float rs = rstd_of(ss_get(ss, r), 1.f / D);
#pragma unroll
        for (int j = 0; j < 4; ++j) { const int c = 256 * j + 4 * lane; const v2u w = *(const v2u*)(HB + (size_t)r * D + c);
            *(f32x4*)(o + c) = (f32x4){bflo(w.x), bfhi(w.x), bflo(w.y), bfhi(w.y)} * rs * *(const f32x4*)(gain + c); }
    }
}
constexpr int P_KS = 400, P_VS = 288, P_VOFF = 64 * P_KS, P_BUF = P_VOFF + 64 * P_VS;
#define ATT_BAR() do { asm volatile("s_waitcnt lgkmcnt(0)" ::: "memory"); __builtin_amdgcn_s_barrier(); asm volatile("" ::: "memory"); } while (0)
struct AttnUnit { int b, h, qb, meta; };
__device__ __forceinline__ void prefill_tile(LAS unsigned char* Kt, LAS unsigned char* Vt, const bf16x8 (&qf)[2][6], f32x4 (&o)[2][8], float (&mrun)[2], float (&lrun)[2], int t, int tq0, int li, int g, const AttnUnit U) {
        const int k0 = 64 * (t - 1);
        if (t == 0 || k0 <= tq0 + 31) {
            f32x4 st[2][4];
#pragma unroll
            for (int nq = 0; nq < 2; ++nq)
#pragma unroll
                for (int kb = 0; kb < 4; ++kb) st[nq][kb] = (f32x4){0.f, 0.f, 0.f, 0.f};
            { const unsigned ka_ = (unsigned)(size_t)(Kt + li * P_KS + 16 * g); bf16x8 kA[3], kB[3];
#define P_RD3(K_, kb_, hf_) do { _Pragma("unroll") for (int s = 0; s < 3; ++s) asm volatile("ds_read_b128 %0, %1 offset:%2" : "=v"(K_[s]) : "v"(ka_), "i"((kb_) * 16 * P_KS + 64 * (3 * (hf_) + s))); } while (0)
#define P_WT3(K_, n_) asm volatile("s_waitcnt lgkmcnt(" #n_ ")" : "+v"(K_[0]), "+v"(K_[1]), "+v"(K_[2]))
#define P_MM3(K_, kb_, hf_) do { _Pragma("unroll") for (int s = 0; s < 3; ++s) { st[0][kb_] = mfma16(K_[s], qf[0][3 * (hf_) + s], st[0][kb_]); st[1][kb_] = mfma16(K_[s], qf[1][3 * (hf_) + s], st[1][kb_]); } } while (0)
              P_RD3(kA, 0, 0);
              P_RD3(kB, 0, 1); P_WT3(kA, 3); P_MM3(kA, 0, 0);
              P_RD3(kA, 1, 0); P_WT3(kB, 3); P_MM3(kB, 0, 1);
              P_RD3(kB, 1, 1); P_WT3(kA, 3); P_MM3(kA, 1, 0);
              P_RD3(kA, 2, 0); P_WT3(kB, 3); P_MM3(kB, 1, 1);
              P_RD3(kB, 2, 1); P_WT3(kA, 3); P_MM3(kA, 2, 0);
              P_RD3(kA, 3, 0); P_WT3(kB, 3); P_MM3(kB, 2, 1);
              P_RD3(kB, 3, 1); P_WT3(kA, 3); P_MM3(kA, 3, 0);
              P_WT3(kB, 0); P_MM3(kB, 3, 1);
#undef P_RD3
#undef P_WT3
#undef P_MM3
            }
            bf16x8 pf[2][2];
#pragma unroll
            for (int nq = 0; nq < 2; ++nq) {
                const int tq = tq0 + 16 * nq + li;
                if (t == 0) {
#pragma unroll
                    for (int kb = 0; kb < 4; ++kb)
#pragma unroll
                        for (int r = 0; r < 4; ++r) { const int key = 16 * kb + 4 * g + r; if (key >= NMETA || (U.meta && key > li)) st[nq][kb][r] = NEG; }
                } else if (k0 + 63 > tq0) {
#pragma unroll
                    for (int kb = 0; kb < 4; ++kb)
#pragma unroll
                        for (int r = 0; r < 4; ++r) { const int key = k0 + 16 * kb + 4 * g + r; if (key > tq) st[nq][kb][r] = NEG; }
                }
                float mx = fmaxf(fmaxf(max4(st[nq][0]), max4(st[nq][1])), fmaxf(max4(st[nq][2]), max4(st[nq][3])));
                mx = xg_max(mx);
                if (__builtin_amdgcn_ballot_w64(mx > mrun[nq]) != 0ull) {
                    const float mnew = fmaxf(mrun[nq], mx), alpha = __builtin_amdgcn_exp2f((mrun[nq] - mnew) * ATT_C); mrun[nq] = mnew; lrun[nq] *= alpha;
#pragma unroll
                    for (int vb = 0; vb < 8; ++vb) o[nq][vb] = o[nq][vb] * alpha;
                }
                const float mc = -mrun[nq] * ATT_C; float rs = 0.f;
#pragma unroll
                for (int kb = 0; kb < 4; ++kb)
#pragma unroll
                    for (int r = 0; r < 4; ++r) { const float p = __builtin_amdgcn_exp2f(fmaf(st[nq][kb][r], ATT_C, mc)); st[nq][kb][r] = p; rs += p; }
                lrun[nq] += xg_sum(rs);
                pf[nq][0] = pack8(st[nq][0], st[nq][1]); pf[nq][1] = pack8(st[nq][2], st[nq][3]);
            }
            { const unsigned va_ = (unsigned)(size_t)(Vt + (4 * g + (li >> 2)) * P_VS + (4 * (li & 3)) * 2); s16x4 vA[4], vB[4];
#define P_RD4(V_, k32_, q_) do { _Pragma("unroll") for (int i = 0; i < 2; ++i) { \
                  asm volatile("ds_read_b64_tr_b16 %0, %1 offset:%2" : "=v"(V_[2 * i]) : "v"(va_), "i"((32 * (k32_)) * P_VS + 32 * (2 * (q_) + i))); \
                  asm volatile("ds_read_b64_tr_b16 %0, %1 offset:%2" : "=v"(V_[2 * i + 1]) : "v"(va_), "i"((32 * (k32_) + 16) * P_VS + 32 * (2 * (q_) + i))); } } while (0)
#define P_WT4(V_, n_) asm volatile("s_waitcnt lgkmcnt(" #n_ ")" : "+v"(V_[0]), "+v"(V_[1]), "+v"(V_[2]), "+v"(V_[3]))
#define P_MM4(V_, k32_, q_) do { _Pragma("unroll") for (int i = 0; i < 2; ++i) { const bf16x8 a = cat4(V_[2 * i], V_[2 * i + 1]); \
                  o[0][2 * (q_) + i] = mfma16(a, pf[0][k32_], o[0][2 * (q_) + i]); o[1][2 * (q_) + i] = mfma16(a, pf[1][k32_], o[1][2 * (q_) + i]); } } while (0)
              P_RD4(vA, 0, 0);
              P_RD4(vB, 0, 1); P_WT4(vA, 4); P_MM4(vA, 0, 0);
              P_RD4(vA, 0, 2); P_WT4(vB, 4); P_MM4(vB, 0, 1);
              P_RD4(vB, 0, 3); P_WT4(vA, 4); P_MM4(vA, 0, 2);
              P_RD4(vA, 1, 0); P_WT4(vB, 4); P_MM4(vB, 0, 3);
              P_RD4(vB, 1, 1); P_WT4(vA, 4); P_MM4(vA, 1, 0);
              P_RD4(vA, 1, 2); P_WT4(vB, 4); P_MM4(vB, 1, 1);
              P_RD4(vB, 1, 3); P_WT4(vA, 4); P_MM4(vA, 1, 2);
              P_WT4(vB, 0); P_MM4(vB, 1, 3);
#undef P_RD4
#undef P_WT4
#undef P_MM4
            }
        }
}
__device__ __forceinline__ void attn_prefill_unit(const Frame& F, const AttnUnit U) {
    const bf16* QN = wsp<bf16>(F.ws, WS_QN); const bf16* QR = wsp<bf16>(F.ws, WS_QR); const bf16* KN = wsp<bf16>(F.ws, WS_KN); const bf16* VV = wsp<bf16>(F.ws, WS_VV);
    const bf16* KRB = wsp<bf16>(F.ws, WS_KRB); bf16* AO = wsp<bf16>(F.ws, WS_AO);
    int tid_ = F.wave * 64 + lane_id_v(); const int tid = tid_, w = __builtin_amdgcn_readfirstlane(tid >> 6), lane = tid & 63, g = lane >> 4, li = lane & 15, h = U.h;
    const int tq0 = U.qb * 256 + 32 * w;
    const int rowq0 = U.meta ? SIDE + 32 * w : U.b * T + tq0;
    const int ntiles = U.meta ? 1 : 1 + 4 * (U.qb + 1);
    bf16x8 qf[2][6];
#pragma unroll
    for (int nq = 0; nq < 2; ++nq) { const size_t row = (size_t)(rowq0 + 16 * nq + li);
#pragma unroll
        for (int s = 0; s < 6; ++s) qf[nq][s] = s < 4 ? *(const bf16x8*)(QN + row * D + h * NOPE + 32 * s + 8 * g) : *(const bf16x8*)(QR + row * 512 + h * ROPE + 32 * (s - 4) + 8 * g); }
    f32x4 o[2][8]; float mrun[2], lrun[2];
#pragma unroll
    for (int nq = 0; nq < 2; ++nq) { mrun[nq] = NEG; lrun[nq] = 0.f;
#pragma unroll
        for (int vb = 0; vb < 8; ++vb) o[nq][vb] = (f32x4){0.f, 0.f, 0.f, 0.f}; }
    v4u kreg[3], vreg[2];
#define P_LOAD_TILE(t_) do { const int keyrow0_ = (t_) == 0 ? SIDE : U.b * T + 64 * ((t_) - 1); \
        _Pragma("unroll") for (int j = 0; j < 3; ++j) { const int c = tid + 512 * j, key = c / 24, ch = c - key * 24; const size_t kr = (size_t)(keyrow0_ + key); \
            kreg[j] = ch < 16 ? *(const v4u*)(KN + kr * D + h * NOPE + 8 * ch) : *(const v4u*)(KRB + kr * ROPE + 8 * (ch - 16)); } \
        _Pragma("unroll") for (int j = 0; j < 2; ++j) { const int c = tid + 512 * j, key = c >> 4, ch = c & 15; vreg[j] = *(const v4u*)(VV + (size_t)(keyrow0_ + key) * D + h * VD + 8 * ch); } } while (0)
#define P_STORE_TILE(buf_) do { LAS unsigned char* kt_ = F.lds + (buf_) * P_BUF; LAS unsigned char* vt_ = kt_ + P_VOFF; \
        _Pragma("unroll") for (int j = 0; j < 3; ++j) { const int c = tid + 512 * j, key = c / 24, ch = c - key * 24; *(LAS v4u*)(kt_ + key * P_KS + ch * 16) = kreg[j]; } \
        _Pragma("unroll") for (int j = 0; j < 2; ++j) { const int c = tid + 512 * j, key = c >> 4, ch = c & 15; *(LAS v4u*)(vt_ + key * P_VS + ch * 16) = vreg[j]; } } while (0)
    P_LOAD_TILE(0); P_STORE_TILE(0); ATT_BAR();
#pragma unroll 1
    for (int t = 0; t < ntiles; ++t) {
        LAS unsigned char* Kt = F.lds + (t & 1) * P_BUF;
        if (t + 1 < ntiles) P_LOAD_TILE(t + 1);
        prefill_tile(Kt, Kt + P_VOFF, qf, o, mrun, lrun, t, tq0, li, g, U);
        if (t + 1 < ntiles) P_STORE_TILE((t + 1) & 1);
        ATT_BAR();
    }
#undef P_LOAD_TILE
#undef P_STORE_TILE
#pragma unroll
    for (int nq = 0; nq < 2; ++nq) {
        if (!U.meta || (w == 0 && nq == 0)) { const float inv = 1.f / lrun[nq]; const size_t row = (size_t)(rowq0 + 16 * nq + li);
#pragma unroll
            for (int vb = 0; vb < 8; ++vb) { const f32x4 v = o[nq][vb] * inv; v2u wv; wv.x = pk2(v[0], v[1]); wv.y = pk2(v[2], v[3]); *(v2u*)(AO + row * D + h * VD + 16 * vb + 4 * g) = wv; } }
    }
    __syncthreads();
}

constexpr int D_KS = 672, D_KT = 64 * D_KS, D_QOFF = 2 * D_KT;
struct DRegs { f32x4 c[8], r[2]; };
constexpr int NSPLIT = 2, PART_STRIDE = 2112;
__device__ __forceinline__ void attn_decode_unit(const Frame& F, const Args& A, int bs, int sp) {
    const bf16* QN = wsp<bf16>(F.ws, WS_QN); const bf16* QR = wsp<bf16>(F.ws, WS_QR);
    const float* CKVF = wsp<float>(F.ws, WS_CKVF); const float* KRF = wsp<float>(F.ws, WS_KRF); const SSR ssc{wsp<float>(F.ws, WS_SSP) + (size_t)SS_CKV * MAIN * 16, wsp<float>(F.ws, WS_SSPS) + (size_t)SS_CKV * 256 * 64};
    const char* cache_ckv = (const char*)A.in[3]; const char* cache_kr = (const char*)A.in[4]; const float* w_uk = A.in[21]; const float* kv_gain = A.in[19];
    const int* ptab = (const int*)A.in[5] + ((AFLAGS & 64) ? 0 : bs * NPG);
    int tid_ = F.wave * 64 + lane_id_v(); const int tid = tid_, w = __builtin_amdgcn_readfirstlane(tid >> 6), lane = tid & 63, g = lane >> 4, li = lane & 15, kg = w & 3, vh = w >> 2; const int srow = SIDE + NMETA + bs;
    LAS unsigned char* qbuf = F.lds + D_QOFF;
    { const int h2 = lane >> 5, nl = lane & 31; const v2u qw = *(const v2u*)(QN + (size_t)srow * D + w * NOPE + 4 * nl);
      const f32x4 qv = {bflo(qw.x), bfhi(qw.x), bflo(qw.y), bfhi(qw.y)};
      const float* wp = w_uk + ((size_t)h2 * HH + w) * NOPE + 4 * nl;
#pragma unroll 1
      for (int i0 = 0; i0 < 128; i0 += 32) { f32x4 wv[32];
#pragma unroll
          for (int i = 0; i < 32; ++i) wv[i] = *(const f32x4*)(wp + (size_t)(i0 + i) * (2 * HH * NOPE));
#pragma unroll
          for (int i = 0; i < 32; ++i) { float p = (qv[0] * wv[i][0] + qv[1] * wv[i][1]) + (qv[2] * wv[i][2] + qv[3] * wv[i][3]); p = scan32(p);
              if (nl == 31) *(LAS bf16*)(qbuf + (w * 320 + 2 * (i0 + i) + h2) * 2) = (bf16)f2bf(p); } } }
    { const int hh = tid >> 6, jj = tid & 63, i = jj >> 1; *(LAS bf16*)(qbuf + (hh * 320 + 256 + ((jj & 1) ? 32 + i : i)) * 2) = QR[(size_t)srow * 512 + hh * ROPE + jj]; }
    for (int i = tid; i < 8 * 320 / 2; i += 512) *(LAS unsigned*)(qbuf + 8 * 640 + 4 * i) = 0u;
    __syncthreads();
    bf16x8 qf[10];
#pragma unroll
    for (int s = 0; s < 10; ++s) qf[s] = *(const LAS bf16x8*)(qbuf + li * 640 + (32 * s + 8 * g) * 2);
    f32x4 o[8]; float mrun = NEG, lrun = 0.f;
#pragma unroll
    for (int vb = 0; vb < 8; ++vb) o[vb] = (f32x4){0.f, 0.f, 0.f, 0.f};
    const float rs_new = rstd_of(ss_get(ssc, srow), 1.f / KVL);
    constexpr int NT = 2 * NPG + 1; const int t0 = sp * 64 + (sp > 0 ? 1 : 0), t1 = (sp + 1) * 64 + 1;
    const unsigned offc = (unsigned)((tid >> 6) * KVL + 4 * (tid & 63)) * 4u, offr = (unsigned)((tid >> 4) * ROPE + 4 * (tid & 15)) * 4u;
    const unsigned ldc = (unsigned)((tid >> 6) * D_KS + (tid & 63) * 8), ldr = (unsigned)((tid >> 4) * D_KS + 512 + (tid & 15) * 8);
    DRegs RA, RB;
#define D_LOAD(R, t_) do { if ((t_) < 2 * NPG) { const int pg_ = __builtin_amdgcn_readfirstlane(ptab[(t_) >> 1]); const size_t row0_ = (size_t)pg_ * PAGE + ((t_) & 1) * 64; \
            const char* cb_ = cache_ckv + row0_ * (KVL * 4); const char* rb_ = cache_kr + row0_ * (ROPE * 4); \
            _Pragma("unroll") for (int j = 0; j < 8; ++j) R.c[j] = __builtin_nontemporal_load((const f32x4*)(cb_ + (offc + (unsigned)j * 8192u))); \
            _Pragma("unroll") for (int j = 0; j < 2; ++j) R.r[j] = __builtin_nontemporal_load((const f32x4*)(rb_ + (offr + (unsigned)j * 8192u))); \
        } else {   \
            _Pragma("unroll") for (int j = 0; j < 8; ++j) R.c[j] = (f32x4){0.f, 0.f, 0.f, 0.f}; \
            _Pragma("unroll") for (int j = 0; j < 2; ++j) R.r[j] = (f32x4){0.f, 0.f, 0.f, 0.f}; \
            if (tid < 64) R.c[0] = *(const f32x4*)(CKVF + (size_t)srow * KVL + 4 * tid) * rs_new * *(const f32x4*)(kv_gain + 4 * tid); \
            if (tid < 16) R.r[0] = *(const f32x4*)(KRF + (size_t)srow * ROPE + 4 * tid); } } while (0)
#define D_TILE(R, t_) do { const int tt_ = (t_); LAS unsigned char* Kt = F.lds + (tt_ & 1) * D_KT; \
        _Pragma("unroll") for (int j = 0; j < 8; ++j) { v2u wv; wv.x = pk2(R.c[j][0], R.c[j][1]); wv.y = pk2(R.c[j][2], R.c[j][3]); *(LAS v2u*)(Kt + ldc + j * (8 * D_KS)) = wv; } \
        _Pragma("unroll") for (int j = 0; j < 2; ++j) { v2u wv; wv.x = pk2(R.r[j][0], R.r[j][1]); wv.y = pk2(R.r[j][2], R.r[j][3]); *(LAS v2u*)(Kt + ldr + j * (32 * D_KS)) = wv; } \
        ATT_BAR();                                                           \
        if (tt_ + 2 < t1) D_LOAD(R, tt_ + 2);                                \
        f32x4 st = {0.f, 0.f, 0.f, 0.f}; \
        { const unsigned ka_ = (unsigned)(size_t)(Kt + (16 * kg + li) * D_KS + 16 * g); bf16x8 dA[5], dB[5];     \
          _Pragma("unroll") for (int s = 0; s < 5; ++s) asm volatile("ds_read_b128 %0, %1 offset:%2" : "=v"(dA[s]) : "v"(ka_), "i"(64 * s)); \
          _Pragma("unroll") for (int s = 0; s < 5; ++s) asm volatile("ds_read_b128 %0, %1 offset:%2" : "=v"(dB[s]) : "v"(ka_), "i"(64 * (5 + s))); \
          asm volatile("s_waitcnt lgkmcnt(5)" : "+v"(dA[0]), "+v"(dA[1]), "+v"(dA[2]), "+v"(dA[3]), "+v"(dA[4])); \
          _Pragma("unroll") for (int s = 0; s < 5; ++s) st = mfma16(dA[s], qf[s], st); \
          asm volatile("s_waitcnt lgkmcnt(0)" : "+v"(dB[0]), "+v"(dB[1]), "+v"(dB[2]), "+v"(dB[3]), "+v"(dB[4])); \
          _Pragma("unroll") for (int s = 0; s < 5; ++s) st = mfma16(dB[s], qf[5 + s], st); } \
        if (tt_ == NT - 1) { \
            _Pragma("unroll") for (int r = 0; r < 4; ++r) if (16 * kg + 4 * g + r != 0) st[r] = NEG; } \
        const float mx = xg_max(max4(st)); \
        if (__builtin_amdgcn_ballot_w64(mx > mrun) != 0ull) {                \
            const float mnew = fmaxf(mrun, mx), alpha = __builtin_amdgcn_exp2f((mrun - mnew) * ATT_C); mrun = mnew; lrun *= alpha; \
            _Pragma("unroll") for (int vb = 0; vb < 8; ++vb) o[vb] = o[vb] * alpha; } \
        float rs = 0.f; \
        _Pragma("unroll") for (int r = 0; r < 4; ++r) { const float p = __builtin_amdgcn_exp2f((st[r] - mrun) * ATT_C); st[r] = p; rs += p; } \
        lrun += xg_sum(rs); \
        const bf16x8 pf = pack8(st, (f32x4){0.f, 0.f, 0.f, 0.f}); \
        LAS unsigned char* ap = Kt + (16 * kg + 4 * g + (li >> 2)) * D_KS + (128 * vh + 4 * (li & 3)) * 2; \
        { const unsigned va_ = (unsigned)(size_t)ap; s16x4 tv[8];                \
          _Pragma("unroll") for (int vb = 0; vb < 8; ++vb) asm volatile("ds_read_b64_tr_b16 %0, %1 offset:%2" : "=v"(tv[vb]) : "v"(va_), "i"(32 * vb)); \
          asm volatile("s_waitcnt lgkmcnt(0)" : "+v"(tv[0]), "+v"(tv[1]), "+v"(tv[2]), "+v"(tv[3]), "+v"(tv[4]), "+v"(tv[5]), "+v"(tv[6]), "+v"(tv[7])); \
          _Pragma("unroll") for (int vb = 0; vb < 8; ++vb) o[vb] = mfma16(cat4(tv[vb], tv[vb]), pf, o[vb]); } } while (0)
    D_LOAD(RA, t0); D_LOAD(RB, t0 + 1);
#pragma unroll 1
    for (int t = t0; t < t1; t += 2) { D_TILE(RA, t); if (t + 1 < t1) D_TILE(RB, t + 1); }
#undef D_LOAD
#undef D_TILE
    __syncthreads();
    LAS float* cm = (LAS float*)(F.lds);
    LAS float* ml = cm + 8 * 8 * 64 * 4;
    if (kg != 0) {
#pragma unroll
        for (int vb = 0; vb < 8; ++vb) *(LAS f32x4*)(cm + ((w * 8 + vb) * 64 + lane) * 4) = o[vb];
        ml[(w * 64 + lane) * 2] = mrun; ml[(w * 64 + lane) * 2 + 1] = lrun;
    }
    __syncthreads();
    if (kg == 0) {
        float mm = mrun;
#pragma unroll
        for (int k = 1; k < 4; ++k) mm = fmaxf(mm, ml[((w + k) * 64 + lane) * 2]);
        const float e0 = __builtin_amdgcn_exp2f((mrun - mm) * ATT_C); float L = lrun * e0;
#pragma unroll
        for (int vb = 0; vb < 8; ++vb) o[vb] = o[vb] * e0;
#pragma unroll
        for (int k = 1; k < 4; ++k) { const float ek = __builtin_amdgcn_exp2f((ml[((w + k) * 64 + lane) * 2] - mm) * ATT_C); L += ml[((w + k) * 64 + lane) * 2 + 1] * ek;
#pragma unroll
            for (int vb = 0; vb < 8; ++vb) o[vb] += *(const LAS f32x4*)(cm + (((w + k) * 8 + vb) * 64 + lane) * 4) * ek; }
        float* part = wsp<float>(F.ws, WS_PART) + (size_t)(((AFLAGS & 64) ? NS * NSPLIT : 0) + bs * NSPLIT + sp) * PART_STRIDE;
        if (li < 8) {
#pragma unroll
            for (int vb = 0; vb < 8; ++vb) *(f32x4*)(part + li * 256 + 128 * vh + 16 * vb + 4 * g) = o[vb];
            if (vh == 0 && g == 0) { part[2048 + li] = mm; part[2056 + li] = L; }
        }
    }
    __syncthreads();
}
__device__ __forceinline__ void attn_combine_unit(const Frame& F, const Args& A, int bs) {
    const int tid = F.wave * 64 + lane_id_v(); const int srow = SIDE + NMETA + bs; const float* w_uv = A.in[22]; bf16* AO = wsp<bf16>(F.ws, WS_AO);
    const float* part = wsp<float>(F.ws, WS_PART) + (size_t)bs * NSPLIT * PART_STRIDE; LAS float* olat = (LAS float*)F.lds;
#pragma unroll 1
    for (int j = 0; j < 4; ++j) { const int idx = tid + 512 * j, hh = idx >> 8; float mm = NEG;
#pragma unroll
        for (int s = 0; s < NSPLIT; ++s) mm = fmaxf(mm, part[s * PART_STRIDE + 2048 + hh]);
        float L = 0.f, ov = 0.f;
#pragma unroll
        for (int s = 0; s < NSPLIT; ++s) { const float e = __builtin_amdgcn_exp2f((part[s * PART_STRIDE + 2048 + hh] - mm) * ATT_C); L += part[s * PART_STRIDE + 2056 + hh] * e; ov += part[s * PART_STRIDE + idx] * e; }
        olat[idx] = ov / L; }
    __syncthreads();
#pragma unroll 1
    for (int j = 0; j < 2; ++j) { const int idx = tid + 512 * j, hh = idx >> 7, v = idx & 127; float s = 0.f;
#pragma unroll 8
        for (int r = 0; r < KVL; ++r) s += olat[hh * 256 + r] * w_uv[((size_t)r * HH + hh) * VD + v];
        AO[(size_t)srow * D + hh * VD + v] = (bf16)f2bf(s); }
    __syncthreads();
}
#define SSRD(i_) (SSR{SSPm + (size_t)(i_) * MAIN * 16, SSPs + (size_t)(i_) * 256 * 64})
#define SSWR(i_) (SSW{SSPm + (size_t)(i_) * MAIN * 16, SSPs + (size_t)(i_) * 256 * 64})
constexpr int NPH = 26;
__global__ void __launch_bounds__(512, 2) yoco_fwd(Args A) {
    extern __shared__ __attribute__((aligned(16))) unsigned char lds_raw[];
    Frame F0; F0.lds = (LAS unsigned char*)lds_raw; F0.wave = __builtin_amdgcn_readfirstlane((int)threadIdx.x >> 6);
    F0.G = gridDim.x; F0.bid = blockIdx.x; F0.ws = A.ws; F0.out = A.out;
    volatile LAS unsigned* MISC = (volatile LAS unsigned*)(F0.lds + LDSCTL_OFF);
    if (threadIdx.x < 64) MISC[threadIdx.x] = 0u;
    __syncthreads();
    const bool fused = PROBE_BUILD ? (A.ph_hi - A.ph_lo) > 1 : true;
    XcdBarrier bar; bar.bar = (unsigned*)(A.ws + WS_CTL) + 4096; bar.x = 0; bar.st = MISC + 8;
    if (fused) bar = xcd_barrier_post((unsigned*)(A.ws + WS_CTL) + 4096, MISC + 8);
    int ph = 0; (void)ph;
#ifndef EN_MASK
#define EN_MASK 0xFFFF
#endif
#ifndef REPEAT_MASK
#define REPEAT_MASK 0ull
#endif
#ifndef PROBE_BUILD
#define PROBE_BUILD 0
#endif
#if PROBE_BUILD
#define PHASE_BEGIN(k) if (ph >= A.ph_lo && ph < A.ph_hi) { if constexpr ((EN_MASK >> (k)) & 1) { Frame F = F0; { GAS unsigned char* wg_ = (GAS unsigned char*)F.ws; GAS float* og_ = (GAS float*)F.out; asm volatile("" : "+s"(wg_), "+s"(og_), "+s"(F.G), "+s"(F.bid), "+s"(F.wave)); F.ws = (unsigned char*)wg_; F.out = (float*)og_; }     \
    float* SSPm = wsp<float>(F.ws, WS_SSP); float* SSPs = wsp<float>(F.ws, WS_SSPS); bf16* HB = wsp<bf16>(F.ws, WS_HB); const float* rope = wsp<float>(F.ws, WS_ROPE); (void)SSPm; (void)SSPs; (void)HB; (void)rope;
#define PHASE_END } if (ph + 1 < A.ph_hi) { XcdBarrier b_ = bar; { GAS unsigned* bg_ = (GAS unsigned*)b_.bar; asm volatile("" : "+s"(bg_), "+s"(b_.x)); b_.bar = (unsigned*)bg_; } xcd_barrier(b_); } } ++ph;
#define PHASE_END_LAST } } ++ph;
#else
#define PHASE_BEGIN(k) { { Frame F = F0; { GAS unsigned char* wg_ = (GAS unsigned char*)F.ws; GAS float* og_ = (GAS float*)F.out; asm volatile("" : "+s"(wg_), "+s"(og_), "+s"(F.G), "+s"(F.bid), "+s"(F.wave)); F.ws = (unsigned char*)wg_; F.out = (float*)og_; }     \
    float* SSPm = wsp<float>(F.ws, WS_SSP); float* SSPs = wsp<float>(F.ws, WS_SSPS); bf16* HB = wsp<bf16>(F.ws, WS_HB); const float* rope = wsp<float>(F.ws, WS_ROPE); (void)SSPm; (void)SSPs; (void)HB; (void)rope;
#define PHASE_END } { XcdBarrier b_ = bar; { GAS unsigned* bg_ = (GAS unsigned*)b_.bar; asm volatile("" : "+s"(bg_), "+s"(b_.x)); b_.bar = (unsigned*)bg_; } xcd_barrier(b_); } }
#define PHASE_END_LAST } }
#endif

    PHASE_BEGIN(0) p0_prologue(F, A); PHASE_END

#pragma unroll 1
    for (int l = 0; l < 4; ++l) {
        if (l < 2) {
            PHASE_BEGIN(1)
                pg8::Gemm g{HB, wsp<bf16>(F.ws, WS_WIN) + (size_t)l * 4096 * 1024, MAIN, 4096, D}; pg8::StaticOrder S; S.init(MAIN, 4096, F.G, F.bid);
                epi::HgIn E{SSRD(2 * l), wsp<bf16>(F.ws, WS_QB), wsp<bf16>(F.ws, WS_KB), wsp<bf16>(F.ws, WS_VB), wsp<bf16>(F.ws, WS_GB), wsp<float>(F.ws, WS_LF), wsp<float>(F.ws, WS_LBT) + l * 3072};
                if (!(AFLAGS & 4)) epi::side_gemm(F, g.A, g.Bt, g.N, g.K, E); if (!(AFLAGS & 8)) { const epi::Big<epi::HgIn> BE{E}; pg8::gemm_phase<epi::Big<epi::HgIn>, pg8::StaticOrder, true, true>(F.lds, g, S, BE, F.wave); }
            PHASE_END
            PHASE_BEGIN(2)
                if (F.G >= 2) { const int half = F.G / 2;
                    if (F.bid < half) { if (AFLAGS & 1) for (int u = F.bid; u < NB * HH; u += half) hg_prompt_unit(F, l, u); }
                    else { if (AFLAGS & 2) { for (int u = F.bid - half; u < NS * HH; u += F.G - half) hg_sample_unit(F, A.in[2], l, u);
                            __syncthreads(); const int lane_ = lane_id_v(); convert_weights(F, A, l == 0 ? TD_P0 : TD_R0, l == 0 ? TD_R0 : TD_ITEMS, (F.bid - half) * 8 + F.wave, (F.G - half) * 8, (LAS float*)(F.lds + F.wave * 16384), lane_); } } }
                else { for (int u = 0; u < NB * HH; ++u) hg_prompt_unit(F, l, u); for (int u = 0; u < NS * HH; ++u) hg_sample_unit(F, A.in[2], l, u);
                    __syncthreads(); const int lane_ = lane_id_v(); convert_weights(F, A, l == 0 ? TD_P0 : TD_R0, l == 0 ? TD_R0 : TD_ITEMS, F.wave, 8, (LAS float*)(F.lds + F.wave * 16384), lane_); }
            PHASE_END
        } else {
            const int j = l - 2;
            if (j == 1) {
                PHASE_BEGIN(4)
                    pg8::Gemm g{HB, wsp<bf16>(F.ws, WS_WDQ1), MAIN, 512, D}; pg8::StaticOrder S; S.init(MAIN, 512, F.G, F.bid);
                    epi::Dq E{SSRD(6), wsp<bf16>(F.ws, WS_CQB), SSWR(SS_CQ1)};
                    if (!(AFLAGS & 4)) epi::side_gemm(F, g.A, g.Bt, g.N, g.K, E); if (!(AFLAGS & 8)) { const epi::Big<epi::Dq> BE{E}; pg8::gemm_phase<epi::Big<epi::Dq>, pg8::StaticOrder, true, true>(F.lds, g, S, BE, F.wave); }
                PHASE_END
            }
            if (j == 1) {
                PHASE_BEGIN(5)
                pg8::Gemm g{wsp<bf16>(F.ws, WS_CQB), wsp<bf16>(F.ws, WS_WUQ) + (size_t)j * 1536 * QL, MAIN, 1536, QL}; pg8::StaticOrder S; S.init(MAIN, 1536, F.G, F.bid);
                epi::Uq E{SSRD(SS_CQ0 + j), wsp<bf16>(F.ws, WS_QN), wsp<bf16>(F.ws, WS_QR), rope};
                if (!(AFLAGS & 4)) epi::side_gemm(F, g.A, g.Bt, g.N, g.K, E); if (!(AFLAGS & 8)) { const epi::Big<epi::Uq> BE{E}; pg8::gemm_phase<epi::Big<epi::Uq>, pg8::StaticOrder, true, true>(F.lds, g, S, BE, F.wave); }
                PHASE_END
            }
            PHASE_BEGIN(6)
                gu32* qctr = (gu32*)(A.ws + WS_CTL) + 8192 + 64 * (j + ((AFLAGS & 32) ? 2 : 0)); volatile LAS int* qslot = (volatile LAS int*)(F.lds + LDSCTL_OFF + 128);
                for (;;) {
                    if (F.wave == 0 && lane_id_v() == 0) *qslot = (int)__hip_atomic_fetch_add(qctr, 1u, __ATOMIC_RELAXED, __HIP_MEMORY_SCOPE_AGENT);
                    __syncthreads();
                    const int idx = __builtin_amdgcn_readfirstlane(*qslot);
                    __syncthreads();
                    if (idx >= 1288) break;
                    if (idx < 512 && (idx & 1)) { if (AFLAGS & 2) attn_decode_unit(F, A, idx >> 2, (idx >> 1) & 1); }
                    else if (AFLAGS & 1) { const bool meta = idx >= 1280; const int pi = idx < 512 ? (idx >> 1) : idx - 256; const int bh = pi & 127, qb = 7 - (pi >> 7);
                        attn_prefill_unit(F, meta ? AttnUnit{0, idx - 1280, 0, 1} : AttnUnit{bh >> 3, bh & 7, qb, 0}); }
                }
            PHASE_END
            PHASE_BEGIN(13)
                for (int n = F.bid; n < NS; n += F.G) attn_combine_unit(F, A, n);
            PHASE_END
        }
        PHASE_BEGIN(7)
            pg8::Gemm g{l < 2 ? wsp<bf16>(F.ws, WS_OB) : wsp<bf16>(F.ws, WS_AO), l < 2 ? wsp<bf16>(F.ws, WS_WHO) + (size_t)l * D * D : wsp<bf16>(F.ws, WS_WO) + (size_t)(l - 2) * D * D, MAIN, D, D};
            pg8::StaticOrder S; S.init(MAIN, D, F.G, F.bid);
            if (l == 0) { const epi::ResT<true> E{A.in[0], HB, SSWR(2 * l + 1), AFLAGS & 16, A.in[6], A.in[1]};
                if (!(AFLAGS & 4)) epi::side_gemm(F, g.A, g.Bt, g.N, g.K, E); if (!(AFLAGS & 8)) { const epi::Big<epi::ResT<true>> BE{E}; pg8::gemm_phase<epi::Big<epi::ResT<true>>, pg8::StaticOrder, true, true>(F.lds, g, S, BE, F.wave); } }
            else { const epi::ResT<false> E{nullptr, HB, SSWR(2 * l + 1), AFLAGS & 16, nullptr, nullptr};
                if (!(AFLAGS & 4)) epi::side_gemm(F, g.A, g.Bt, g.N, g.K, E); if (!(AFLAGS & 8)) { const epi::Big<epi::ResT<false>> BE{E}; pg8::gemm_phase<epi::Big<epi::ResT<false>>, pg8::StaticOrder, true, true>(F.lds, g, S, BE, F.wave); } }
        PHASE_END
        PHASE_BEGIN(8)
            pg8::Gemm g{HB, wsp<bf16>(F.ws, WS_WUP) + (size_t)l * FF * D, MAIN, FF, D}; pg8::StaticOrder S; S.init(MAIN, FF, F.G, F.bid);
            epi::Up E{SSRD(2 * l + 1), wsp<bf16>(F.ws, WS_HID)};
            if (!(AFLAGS & 4)) epi::side_gemm(F, g.A, g.Bt, g.N, g.K, E); if (!(AFLAGS & 8)) { const epi::Big<epi::Up> BE{E}; pg8::gemm_phase<epi::Big<epi::Up>, pg8::StaticOrder, true, true>(F.lds, g, S, BE, F.wave); }
        PHASE_END
        PHASE_BEGIN(9)
            pg8::Gemm g{wsp<bf16>(F.ws, WS_HID), wsp<bf16>(F.ws, WS_WDN) + (size_t)l * FF * D, MAIN, D, FF}; pg8::StaticOrder S; S.init(MAIN, D, F.G, F.bid);
            const epi::ResT<false> E{nullptr, HB, SSWR(2 * l + 2), AFLAGS & 16, nullptr, nullptr};
            if (!(AFLAGS & 4)) epi::side_gemm(F, g.A, g.Bt, g.N, g.K, E); if (!(AFLAGS & 8)) { const epi::Big<epi::ResT<false>> BE{E}; pg8::gemm_phase<epi::Big<epi::ResT<false>>, pg8::StaticOrder, true, true>(F.lds, g, S, BE, F.wave); }
        PHASE_END
        if (l == 1) {
            PHASE_BEGIN(10)
                pg8::Gemm g{HB, wsp<bf16>(F.ws, WS_WKVQ), MAIN, 768, D}; pg8::StaticOrder S; S.init(MAIN, 768, F.G, F.bid);
                epi::KvQ E{SSRD(4), wsp<float>(F.ws, WS_CKVF), wsp<bf16>(F.ws, WS_CKVB), wsp<float>(F.ws, WS_KRF), wsp<bf16>(F.ws, WS_KRB), wsp<bf16>(F.ws, WS_CQB), SSWR(SS_CKV), SSWR(SS_CQ0), rope};
                if (!(AFLAGS & 4)) epi::side_gemm(F, g.A, g.Bt, g.N, g.K, E); if (!(AFLAGS & 8)) { const epi::Big<epi::KvQ> BE{E}; pg8::gemm_phase<epi::Big<epi::KvQ>, pg8::StaticOrder, true, true>(F.lds, g, S, BE, F.wave); }
            PHASE_END
            PHASE_BEGIN(11)
                pg8::Gemm g{wsp<bf16>(F.ws, WS_CKVB), wsp<bf16>(F.ws, WS_WUKV), MAIN, 2048, KVL}; pg8::StaticOrder S; S.init(MAIN, 2048, F.G, F.bid);
                epi::KvUp E{SSRD(SS_CKV), wsp<bf16>(F.ws, WS_KN), wsp<bf16>(F.ws, WS_VV)};
                if (!(AFLAGS & 4)) epi::side_gemm(F, g.A, g.Bt, g.N, g.K, E); if (!(AFLAGS & 8)) { const epi::Big<epi::KvUp> BE{E}; pg8::gemm_phase<epi::Big<epi::KvUp>, pg8::StaticOrder, true, true>(F.lds, g, S, BE, F.wave); }
                kv_outputs(F, A.in[19]);
                pg8::Gemm g2{wsp<bf16>(F.ws, WS_CQB), wsp<bf16>(F.ws, WS_WUQ) + (size_t)0 * 1536 * QL, MAIN, 1536, QL}; pg8::StaticOrder S2; S2.init(MAIN, 1536, F.G, F.bid);
                epi::Uq E2{SSRD(SS_CQ0 + 0), wsp<bf16>(F.ws, WS_QN), wsp<bf16>(F.ws, WS_QR), rope};
                if (!(AFLAGS & 4)) epi::side_gemm(F, g2.A, g2.Bt, g2.N, g2.K, E2); if (!(AFLAGS & 8)) { const epi::Big<epi::Uq> BE2{E2}; pg8::gemm_phase<epi::Big<epi::Uq>, pg8::StaticOrder, true, true>(F.lds, g2, S2, BE2, F.wave); }
            PHASE_END
        }
    }
    PHASE_BEGIN(12) final_norm(F, A.in[9]); PHASE_END_LAST
}

#ifndef REPEAT_FLAGS
#define REPEAT_FLAGS 3
#endif
#ifndef N_LAUNCH_MODE
#define N_LAUNCH_MODE 1
#endif
extern "C" void kernel_launch(void* const* d_in, const int* in_sizes, int n_in, void* d_out, int out_size, void* d_ws, size_t ws_size, hipStream_t stream) {
    static int grid = 0;
    if (grid == 0) {
        if (n_in != 29 || out_size != (int)O_END || ws_size < WS_END) { fprintf(stderr, "kernel_launch: unexpected shapes (n_in %d, out %d, ws %zu < %zu)\n", n_in, out_size, ws_size, (size_t)WS_END); grid = -1; return; }
        int dev = 0, cus = 0, per_cu = 0;
        if (hipGetDevice(&dev) != hipSuccess || hipDeviceGetAttribute(&cus, hipDeviceAttributeMultiprocessorCount, dev) != hipSuccess) { grid = -1; return; }
        if (hipFuncSetAttribute((const void*)yoco_fwd, hipFuncAttributeMaxDynamicSharedMemorySize, LDS_BYTES) != hipSuccess) { fprintf(stderr, "kernel_launch: hipFuncSetAttribute failed\n"); grid = -1; return; }
        if (hipOccupancyMaxActiveBlocksPerMultiprocessor(&per_cu, (const void*)yoco_fwd, 512, LDS_BYTES) != hipSuccess || per_cu < 1) fprintf(stderr, "kernel_launch: occupancy query says %d\n", per_cu);
        (void)hipGetLastError();
        grid = cus;
    }
    if (grid < 0) return;
    (void)hipMemsetAsync((char*)d_ws + WS_CTL, 0, CTL_BYTES, stream);
    Args a{};
    for (int i = 0; i < 29; ++i) a.in[i] = (const float*)d_in[i];
    a.out = (float*)d_out; a.ws = (unsigned char*)d_ws; a.flags = 3;
    if (N_LAUNCH_MODE == 1) { a.ph_lo = 0; a.ph_hi = NPH; hipLaunchKernelGGL(yoco_fwd, dim3(grid), dim3(512), LDS_BYTES, stream, a); }
    else for (int p = 0; p < NPH; ++p) { a.ph_lo = p; a.ph_hi = p + 1; const int reps = ((REPEAT_MASK >> p) & 1ull) ? 2 : 1;
        for (int r = 0; r < reps; ++r) { a.flags = r ? REPEAT_FLAGS : 3; static_assert(PROBE_BUILD || N_LAUNCH_MODE == 1, "multi-launch needs PROBE_BUILD"); hipLaunchKernelGGL(yoco_fwd, dim3(grid), dim3(512), LDS_BYTES, stream, a); } }
}
```

```cpp
#include <hip/hip_runtime.h>
#include <cstdio>
#include <cstdint>
#include <cmath>

#define GAS __attribute__((address_space(1)))
#define LAS __attribute__((address_space(3)))
typedef unsigned short bf16;
typedef unsigned v4u __attribute__((ext_vector_type(4)));
typedef unsigned v2u __attribute__((ext_vector_type(2)));
typedef float f32x4 __attribute__((ext_vector_type(4)));
typedef float f32x2 __attribute__((ext_vector_type(2)));
typedef short bf16x8 __attribute__((ext_vector_type(8)));
typedef short s16x4 __attribute__((ext_vector_type(4)));
typedef GAS unsigned gu32;
#define RLX_AGENT __ATOMIC_RELAXED, __HIP_MEMORY_SCOPE_AGENT

#ifndef PROBE_BUILD
#define PROBE_BUILD 0
#endif
#if PROBE_BUILD
#define AFLAGS (A.flags)
#else
#define AFLAGS 3
#endif
constexpr int D = 1024, NB = 16, T = 2048, NMETA = 16, NS = 128, FF = 4096;
constexpr int MAIN = NB * T;
constexpr int SIDE = MAIN;
constexpr int NSIDE = NMETA + NS;
constexpr int M = MAIN + 256;
constexpr int HH = 8, HK = 128, HV = 128;
constexpr int KVL = 256, QL = 384, NOPE = 128, ROPE = 64, VD = 128, PAST = 8192, PAGE = 128, NPG = PAST / PAGE;
constexpr float EPS = 1e-6f;
constexpr float ATT_C = 0.07216878364870322f * 1.4426950408889634f;
constexpr int LPROMPT = NMETA + T;
constexpr int ROPE_SLOTS = LPROMPT + 1;

constexpr size_t O_Y = 0, O_YS = O_Y + (size_t)NB * T * D, O_SP = O_YS + (size_t)NS * D, O_CKVP = O_SP + (size_t)2 * NB * HH * HK * HV,
                 O_KRP = O_CKVP + (size_t)NB * LPROMPT * KVL, O_SS = O_KRP + (size_t)NB * LPROMPT * ROPE, O_CKVS = O_SS + (size_t)2 * NS * HH * HK * HV,
                 O_KRS = O_CKVS + (size_t)NS * KVL, O_END = O_KRS + (size_t)NS * ROPE;
static_assert(O_END == 82042880, "output size");

constexpr size_t al(size_t x) { return (x + 4095) & ~(size_t)4095; }
constexpr size_t WS_CTL = 0, CTL_BYTES = 1u << 20;
constexpr size_t WS_WIN = WS_CTL + CTL_BYTES;
constexpr size_t WS_WHO = WS_WIN + (size_t)2 * 4096 * 1024 * 2;
constexpr size_t WS_WUP = WS_WHO + (size_t)2 * 1024 * 1024 * 2;
constexpr size_t WS_WDN = WS_WUP + (size_t)4 * 4096 * 1024 * 2;
constexpr size_t WS_WKVQ = WS_WDN + (size_t)4 * 4096 * 1024 * 2;
constexpr size_t WS_WDQ1 = WS_WKVQ + (size_t)768 * 1024 * 2;
constexpr size_t WS_WUQ = WS_WDQ1 + (size_t)512 * 1024 * 2;
constexpr size_t WS_WO = WS_WUQ + (size_t)2 * 1536 * 384 * 2;
constexpr size_t WS_WUKV = WS_WO + (size_t)2 * 1024 * 1024 * 2;
constexpr size_t WS_ROPE = al(WS_WUKV + (size_t)2048 * 256 * 2);
constexpr size_t WS_LBT = al(WS_ROPE + (size_t)ROPE_SLOTS * 64 * 4);
constexpr size_t WS_SS = al(WS_LBT + (size_t)2 * 3 * 1024 * 4);
constexpr int NSS = 12;
constexpr size_t WS_H = al(WS_SS + (size_t)NSS * M * 4);
constexpr size_t WS_HB = al(WS_H + (size_t)M * D * 4);
constexpr size_t WS_QB = al(WS_HB + (size_t)M * D * 2);
constexpr size_t WS_KB = al(WS_QB + (size_t)M * D * 2);
constexpr size_t WS_VB = al(WS_KB + (size_t)M * D * 2);
constexpr size_t WS_GB = al(WS_VB + (size_t)M * D * 2);
constexpr size_t WS_LF = al(WS_GB + (size_t)M * D * 2);
constexpr size_t WS_ORAW = al(WS_LF + (size_t)M * D * 4);
constexpr size_t WS_OB = al(WS_ORAW + (size_t)M * D * 4);
constexpr size_t WS_HID = al(WS_OB + (size_t)M * D * 2);
constexpr size_t WS_CKVF = al(WS_HID + (size_t)M * FF * 2);
constexpr size_t WS_CKVB = al(WS_CKVF + (size_t)M * KVL * 4);
constexpr size_t WS_KRF = al(WS_CKVB + (size_t)M * KVL * 2);
constexpr size_t WS_KRB = al(WS_KRF + (size_t)M * ROPE * 4);
constexpr size_t WS_CQB = al(WS_KRB + (size_t)M * ROPE * 2);
constexpr size_t WS_QN = al(WS_CQB + (size_t)M * QL * 2);
constexpr size_t WS_QR = al(WS_QN + (size_t)M * D * 2);
constexpr size_t WS_KN = al(WS_QR + (size_t)M * 512 * 2);
constexpr size_t WS_VV = al(WS_KN + (size_t)M * D * 2);
constexpr size_t WS_AO = al(WS_VV + (size_t)M * D * 2);
constexpr size_t WS_PART = al(WS_AO + (size_t)M * D * 2);
constexpr size_t WS_SSP = al(WS_PART + (size_t)2 * NS * 4 * 2112 * 4);
constexpr size_t WS_SSPS = al(WS_SSP + (size_t)12 * 32768 * 16 * 4);
constexpr size_t WS_END = al(WS_SSPS + (size_t)12 * 256 * 64 * 4);
enum { SS_H0 = 0, SS_CKV = 9, SS_CQ0 = 10, SS_CQ1 = 11 };

constexpr int RING_BYTES = 131072, LDSCTL_OFF = RING_BYTES, LDS_BYTES = 147456;

#define LDS_WAIT() asm volatile("s_waitcnt lgkmcnt(0)" ::: "memory")
#define VM_WAIT() asm volatile("s_waitcnt vmcnt(0)" ::: "memory")
__device__ __forceinline__ unsigned f2bf(float f) { unsigned u = __builtin_bit_cast(unsigned, f); return (u + 0x7fffu + ((u >> 16) & 1u)) >> 16; }
typedef __bf16 bf16x2_t __attribute__((ext_vector_type(2)));
__device__ __forceinline__ unsigned pk2(float lo, float hi) { const f32x2 v = {lo, hi}; return __builtin_bit_cast(unsigned, __builtin_convertvector(v, bf16x2_t)); }
__device__ __forceinline__ float bf2f(unsigned short b) { return __builtin_bit_cast(float, (unsigned)b << 16); }
__device__ __forceinline__ float bflo(unsigned w) { return __builtin_bit_cast(float, w << 16); }
__device__ __forceinline__ float bfhi(unsigned w) { return __builtin_bit_cast(float, w & 0xffff0000u); }
__device__ __forceinline__ float rstd_of(float ss, float inv_n) { return __builtin_amdgcn_rsqf(ss * inv_n + EPS); }
__device__ __forceinline__ int pos_slot(int row) { return row < MAIN ? NMETA + (row & (T - 1)) : (row - SIDE < NMETA ? row - SIDE : (row - SIDE < NSIDE ? LPROMPT : 0)); }
__device__ __forceinline__ int lane_id_v() { int l; asm volatile("v_mbcnt_lo_u32_b32 %0, -1, 0\n\tv_mbcnt_hi_u32_b32 %0, -1, %0" : "=v"(l)); return l; }
__device__ __forceinline__ f32x4 mfma16(bf16x8 a, bf16x8 b, f32x4 c) { return __builtin_amdgcn_mfma_f32_16x16x32_bf16(a, b, c, 0, 0, 0); }
__device__ __forceinline__ s16x4 tr_rd(LAS unsigned char* p) { return __builtin_amdgcn_ds_read_tr16_b64_v4i16((LAS s16x4*)p); }
__device__ __forceinline__ bf16x8 cat4(s16x4 lo, s16x4 hi) { bf16x8 r = {lo[0], lo[1], lo[2], lo[3], hi[0], hi[1], hi[2], hi[3]}; return r; }
__device__ __forceinline__ bf16x8 pack8(f32x4 a, f32x4 b) { v4u w; w.x = pk2(a[0], a[1]); w.y = pk2(a[2], a[3]); w.z = pk2(b[0], b[1]); w.w = pk2(b[2], b[3]); return __builtin_bit_cast(bf16x8, w); }
__device__ __forceinline__ float max4(f32x4 v) { return fmaxf(fmaxf(v[0], v[1]), fmaxf(v[2], v[3])); }
constexpr float NEG = -1e30f;

template <int N> __device__ __forceinline__ float dpp_ror(float x) { return __builtin_bit_cast(float, __builtin_amdgcn_update_dpp(0, __builtin_bit_cast(int, x), 0x120 + N, 0xf, 0xf, false)); }
__device__ __forceinline__ float row_sum16(float x) { x += dpp_ror<8>(x); x += dpp_ror<4>(x); x += dpp_ror<2>(x); x += dpp_ror<1>(x); return x; }
__device__ __forceinline__ float u2f(unsigned u) { return __builtin_bit_cast(float, u); }
__device__ __forceinline__ unsigned f2u(float f) { return __builtin_bit_cast(unsigned, f); }
__device__ __forceinline__ float xg_max(float x) {
    auto s = __builtin_amdgcn_permlane16_swap(f2u(x), f2u(x), false, false); const unsigned s0 = s[0], s1 = s[1];
    x = fmaxf(u2f(s0), u2f(s1));
    auto t = __builtin_amdgcn_permlane32_swap(f2u(x), f2u(x), false, false); const unsigned t0 = t[0], t1 = t[1];
    return fmaxf(u2f(t0), u2f(t1));
}
__device__ __forceinline__ float xg_sum(float x) {
    auto s = __builtin_amdgcn_permlane16_swap(f2u(x), f2u(x), false, false); const unsigned s0 = s[0], s1 = s[1];
    x = u2f(s0) + u2f(s1);
    auto t = __builtin_amdgcn_permlane32_swap(f2u(x), f2u(x), false, false); const unsigned t0 = t[0], t1 = t[1];
    return u2f(t0) + u2f(t1);
}
__device__ __forceinline__ float half_sum(float x) {
    auto t = __builtin_amdgcn_permlane32_swap(f2u(x), f2u(x), false, false); const unsigned t0 = t[0], t1 = t[1];
    return u2f(t0) + u2f(t1);
}
__device__ __forceinline__ float row_scan4(float x, int row) {
    auto s = __builtin_amdgcn_permlane16_swap(f2u(x), f2u(x), false, false); const unsigned s0 = s[0], s1 = s[1];
    const float y = (row & 1) ? u2f(s0) + u2f(s1) : x;
    auto t = __builtin_amdgcn_permlane32_swap(f2u(y), f2u(y), false, false); const unsigned t0 = t[0];
    auto u = __builtin_amdgcn_permlane16_swap(t0, t0, false, false); const unsigned u1 = u[1];
    return (row & 2) ? y + u2f(u1) : y;
}
struct SSR { const float* m; const float* s; };
struct SSW { float* m; float* s; };
__device__ __forceinline__ float ss_get(const SSR r, int row) {
    if (row < SIDE) { const f32x4* p = (const f32x4*)(r.m + (size_t)row * 16); const f32x4 a = p[0] + p[1], b = p[2] + p[3]; const f32x4 c = a + b; return (c[0] + c[1]) + (c[2] + c[3]); }
    const f32x4* p = (const f32x4*)(r.s + (size_t)(row - SIDE) * 64); f32x4 c = p[0];
#pragma unroll
    for (int i = 1; i < 16; ++i) c += p[i];
    return (c[0] + c[1]) + (c[2] + c[3]);
}
#define XB_TMO      128
#define XB_XCNT(j)  (256  + 64 * (j))
#define XB_XSUB(j)  (1280 + 64 * (j))
#define XB_XGEN(j)  (2304 + 64 * (j))
#define XB_TOP      3328
#define XB_TOPGEN   3392
#define XCD_BAR_WORDS 3456
#define XB_SPIN_CAP (1u << 18)

__device__ __forceinline__ unsigned xb_ld(unsigned* p)              { return __hip_atomic_load(p, __ATOMIC_RELAXED, __HIP_MEMORY_SCOPE_AGENT); }
__device__ __forceinline__ unsigned xb_add(unsigned* p, unsigned v) { return __hip_atomic_fetch_add(p, v, __ATOMIC_RELAXED, __HIP_MEMORY_SCOPE_AGENT); }
__device__ __forceinline__ unsigned xb_xcc_id() { return (unsigned)__builtin_amdgcn_s_getreg((3 << 11) | 20) & 0xFu; }
#define XB_SPIN(cond, bar) do { unsigned _sp = 0; while (cond) { __builtin_amdgcn_s_sleep(1); \
    if ((++_sp & 255u) == 0u) { if (xb_ld(&(bar)[XB_TMO])) break; if (_sp > XB_SPIN_CAP) { atomicAdd(&(bar)[XB_TMO], 1u); break; } } } } while (0)

struct XcdBarrier {
    unsigned* bar; unsigned x;
    volatile LAS unsigned* st;
};

__device__ __forceinline__ XcdBarrier xcd_barrier_post(unsigned* bar, volatile LAS unsigned* st) {
    XcdBarrier b; b.bar = bar; b.x = xb_xcc_id(); b.st = st;
    if (threadIdx.x == 0) (void)xb_add(&bar[XB_XCNT(b.x)], 1u);
    return b;
}
__device__ __forceinline__ void xcd_barrier_complete(unsigned* bar, unsigned x, unsigned& nloc, unsigned& nx) {
    const unsigned G = gridDim.x * gridDim.y * gridDim.z;
    unsigned sum, cnt, mine, sp = 0u;
    for (;;) {
        sum = 0u; cnt = 0u; mine = 0u;
#pragma unroll
        for (unsigned j = 0; j < 16; ++j) { const unsigned c = xb_ld(&bar[XB_XCNT(j)]); sum += c; cnt += (c > 0u) ? 1u : 0u; mine = (j == x) ? c : mine; }
        if (sum == G) break;
        __builtin_amdgcn_s_sleep(1);
        if ((++sp & 255u) == 0u) { if (xb_ld(&bar[XB_TMO])) break; if (sp > XB_SPIN_CAP) { atomicAdd(&bar[XB_TMO], 1u); break; } }
    }
    nloc = mine > 0u ? mine : 1u; nx = cnt > 0u ? cnt : 1u;
}

__device__ __forceinline__ void xcd_barrier(const XcdBarrier& b) {
    asm volatile("s_waitcnt vmcnt(0)" ::: "memory");
    __syncthreads();
    if (threadIdx.x == 0) {
        unsigned* bar = b.bar;
        __builtin_amdgcn_s_waitcnt(0);
        unsigned nloc = b.st[0], nx = b.st[1];
        if (nloc == 0u) { xcd_barrier_complete(bar, b.x, nloc, nx); b.st[0] = nloc; b.st[1] = nx; }
        const unsigned old = xb_add(&bar[XB_XSUB(b.x)], 1u);
        const unsigned gen = old / nloc;
        if (old + 1u == (gen + 1u) * nloc) {
            __builtin_amdgcn_fence(__ATOMIC_RELEASE, "agent");
            asm volatile("s_waitcnt vmcnt(0)" ::: "memory");
            const unsigned og = xb_add(&bar[XB_TOP], 1u);
            const unsigned tg = og / nx;
            if (og + 1u == (tg + 1u) * nx) xb_add(&bar[XB_TOPGEN], 1u);
            else XB_SPIN(xb_ld(&bar[XB_TOPGEN]) == tg, bar);
            __builtin_amdgcn_fence(__ATOMIC_ACQUIRE, "agent");
            xb_add(&bar[XB_XGEN(b.x)], 1u);
            asm volatile("s_waitcnt vmcnt(0)" ::: "memory");
        } else {
            XB_SPIN(xb_ld(&bar[XB_XGEN(b.x)]) == gen, bar);
            __builtin_amdgcn_fence(__ATOMIC_ACQUIRE, "agent");
            asm volatile("s_waitcnt vmcnt(0)" ::: "memory");
        }
    }
    __syncthreads();
}
namespace pg8 {
#define PG8_LAS __attribute__((address_space(3)))
typedef unsigned short bf16_t;
typedef short bf16x8 __attribute__((ext_vector_type(8)));
typedef float f32x4 __attribute__((ext_vector_type(4)));
typedef unsigned u32x4 __attribute__((ext_vector_type(4)));
constexpr int BM = 256, BK = 64, HALF = 128, HTB = HALF * BK * 2  , STAGE_BYTES = 8 * HTB, NXCD = 8, WGM = 8;

__host__ __device__ __forceinline__ int lds_byte(int r, int c) { const int st = (r >> 4) * 2 + (c >> 5), rr = r & 15, cc = c & 31, ob = rr * 64 + cc * 2; return st * 1024 + (ob ^ (((ob >> 9) & 1) << 5)); }
__host__ __device__ __forceinline__ void stage_rc(int b, int& R, int& C) { const int st = b / 1024, sb = b % 1024, swz = sb ^ (((sb >> 9) & 1) << 5); R = (st >> 1) * 16 + swz / 64; C = (st & 1) * 32 + (swz % 64) / 2; }
__host__ __device__ __forceinline__ int perm32(int rho) { const int n = rho >> 4, i = rho & 15; return 8 * (i >> 2) + 4 * n + (i & 3); }
__host__ __device__ __forceinline__ int perm256(int R) { const int wc = R >> 5, n = (R >> 4) & 1, i = R & 15; return 64 * wc + 16 * (i >> 2) + 4 * n + (i & 3); }

struct Unit { int pm, pn; };
struct Gemm { const bf16_t* A; const bf16_t* Bt; int M, N, K; };

struct StaticOrder {
    int nM, nN, nwg, G, c;
    __host__ __device__ void init(int M, int N, int G_, int c_) { nM = M / BM; nN = N / BM; nwg = nM * nN; G = G_; c = c_; }
    __host__ __device__ bool next(int i, Unit& u) const {
        const long L = (long)i * G + c; if (L >= nwg) return false;
        int wgid = (int)L; { const int q = nwg / NXCD, r = nwg % NXCD, xcd = wgid % NXCD, off = wgid / NXCD; wgid = (xcd < r ? xcd * (q + 1) : r * (q + 1) + (xcd - r) * q) + off; }
        const int nig = WGM * nN, gid = wgid / nig, fm = gid * WGM, gsz = (nM - fm) < WGM ? (nM - fm) : WGM;
        u.pm = fm + ((wgid % nig) % gsz); u.pn = (wgid % nig) / gsz; return true;
    }
    __device__ __forceinline__ void a_ready(const Unit&) const {}
    __device__ __forceinline__ void done(const Unit&) const {}
};

template <class Epi, class Sched, bool ALIGN_EPI = false, bool SP2 = false>
__device__ __forceinline__ void gemm_phase(PG8_LAS unsigned char* lds, const Gemm g, const Sched& S, const Epi& E, const int wave_sgpr) {
    int tid_ = wave_sgpr * 64 + lane_id_v();
    const int tid = tid_, wid = __builtin_amdgcn_readfirstlane(tid >> 6), lane = tid & 63, wr = wid >> 2, wc = wid & 3, fr = lane & 15, fq = lane >> 4;
    const int K = g.K, nt = K / BK;
    unsigned voffA[2], voffB[2];
#pragma unroll
    for (int i = 0; i < 2; ++i) { int R, C; stage_rc(tid * 16 + i * 8192, R, C); const int Rb = Epi::PERM ? perm256(R) : R;
        voffA[i] = (unsigned)(R * K + C) * 2u; voffB[i] = (unsigned)(Rb * K + C) * 2u; }
    const size_t kstep = (size_t)(BK * 2);
    const size_t hstep = (size_t)HALF * K * 2;
    const size_t hstepB = Epi::PERM ? (size_t)8 * K * 2 : hstep;
    const size_t tstep = 2 * hstep;
    const unsigned ldsw = (unsigned)wid * 1024u;
    const int aoff = lds_byte(wr * 64 + fr, fq * 8), boff = lds_byte(wc * 32 + fr, fq * 8);
#define PG8_SA(b, h) (((b) * 2 + (h)) * HTB)
#define PG8_SB(b, h) ((4 + (b) * 2 + (h)) * HTB)
#define PG8_STAGE(bufoff, gbase, voff) do { _Pragma("unroll") for (int _i = 0; _i < 2; ++_i) \
        __builtin_amdgcn_global_load_lds((const unsigned*)((const char*)(gbase) + (voff)[_i]), (PG8_LAS unsigned*)(lds + (bufoff) + ldsw + _i * 8192), 16, 0, 0); } while (0)
#define PG8_LDA(dst, b, h) do { _Pragma("unroll") for (int m = 0; m < 4; ++m) _Pragma("unroll") for (int k = 0; k < 2; ++k) dst[m][k] = *(const PG8_LAS bf16x8*)(lds + PG8_SA(b, h) + aoff + m * 2048 + k * 1024); } while (0)
#define PG8_LDB(dst, b, h) do { _Pragma("unroll") for (int n = 0; n < 2; ++n) _Pragma("unroll") for (int k = 0; k < 2; ++k) dst[n][k] = *(const PG8_LAS bf16x8*)(lds + PG8_SB(b, h) + boff + n * 2048 + k * 1024); } while (0)
#define PG8_MMA(ai, bj, At, Bt) do { __builtin_amdgcn_s_setprio(1); _Pragma("unroll") for (int m = 0; m < 4; ++m) _Pragma("unroll") for (int n = 0; n < 2; ++n) _Pragma("unroll") for (int k = 0; k < 2; ++k) \
        acc[ai][bj][m][n] = __builtin_amdgcn_mfma_f32_16x16x32_bf16(Bt[n][k], At[m][k], acc[ai][bj][m][n], 0, 0, 0); __builtin_amdgcn_s_setprio(0); } while (0)
#define PG8_WAIT_V(n) asm volatile("s_waitcnt vmcnt(" #n ")" ::: "memory")
#define PG8_WAIT_L(n) asm volatile("s_waitcnt lgkmcnt(" #n ")" ::: "memory")
#define PG8_BAR __builtin_amdgcn_s_barrier()
#define PG8_SCHED __builtin_amdgcn_sched_barrier(0)
    Unit cur, nxt; int ui = 0;
    if (!S.next(0, cur)) return;
    f32x4 acc[2][2][4][2];
#pragma unroll
    for (int a = 0; a < 2; ++a)
#pragma unroll
        for (int b = 0; b < 2; ++b)
#pragma unroll
            for (int m = 0; m < 4; ++m)
#pragma unroll
                for (int n = 0; n < 2; ++n) acc[a][b][m][n] = (f32x4){0.f, 0.f, 0.f, 0.f};
    bf16x8 At[4][2], B0[2][2], B1[2][2];
    const char* cA = (const char*)g.A + (size_t)cur.pm * tstep; const char* cB = (const char*)g.Bt + (size_t)cur.pn * tstep;
    S.a_ready(cur);
    if constexpr (SP2) {
        PG8_STAGE(PG8_SB(0, 0), cB, voffB); PG8_STAGE(PG8_SB(0, 1), cB + hstepB, voffB); PG8_STAGE(PG8_SA(0, 0), cA, voffA); PG8_STAGE(PG8_SA(0, 1), cA + hstep, voffA);
        if (wr == 1) PG8_BAR;
        PG8_WAIT_V(2); PG8_BAR;
        PG8_STAGE(PG8_SB(1, 0), cB + kstep, voffB); PG8_STAGE(PG8_SA(1, 0), cA + kstep, voffA); PG8_STAGE(PG8_SB(1, 1), cB + hstepB + kstep, voffB);
        PG8_WAIT_V(6); PG8_BAR;
    } else {
        PG8_STAGE(PG8_SB(0, 0), cB, voffB); PG8_STAGE(PG8_SA(0, 0), cA, voffA); PG8_STAGE(PG8_SB(0, 1), cB + hstepB, voffB); PG8_STAGE(PG8_SA(0, 1), cA + hstep, voffA);
        if (wr == 1) PG8_BAR;
        PG8_WAIT_V(4); PG8_BAR;
        PG8_STAGE(PG8_SB(1, 0), cB + kstep, voffB); PG8_STAGE(PG8_SA(1, 0), cA + kstep, voffA); PG8_STAGE(PG8_SB(1, 1), cB + hstepB + kstep, voffB);
        PG8_WAIT_V(6); PG8_BAR;
    }
    for (;;) {
        const bool has_next = S.next(ui + 1, nxt);
        const char* nA = has_next ? (const char*)g.A + (size_t)nxt.pm * tstep : cA; const char* nB = has_next ? (const char*)g.Bt + (size_t)nxt.pn * tstep : cB;
        for (int t = 0; t < nt; t += 2) {
            const bool last = (t == nt - 2);
            const char* a1 = cA + (size_t)(t + 1) * kstep;
            const char* a2 = last ? nA : cA + (size_t)(t + 2) * kstep; const char* b2 = last ? nB : cB + (size_t)(t + 2) * kstep;
            const char* a3 = a2 + kstep; const char* b3 = b2 + kstep;
            if (last && has_next) S.a_ready(nxt);
            if constexpr (SP2) {
            PG8_LDB(B0, 0, 0); PG8_LDB(B1, 0, 1); PG8_SCHED; PG8_LDA(At, 0, 0); PG8_STAGE(PG8_SA(1, 1), a1 + hstep, voffA);
            PG8_WAIT_V(8); PG8_WAIT_L(0); PG8_BAR; PG8_MMA(0, 0, At, B0); PG8_MMA(0, 1, At, B1); PG8_BAR; PG8_SCHED;
            PG8_LDA(At, 0, 1); PG8_STAGE(PG8_SB(0, 0), b2, voffB); PG8_STAGE(PG8_SB(0, 1), b2 + hstepB, voffB); PG8_STAGE(PG8_SA(0, 0), a2, voffA);
            PG8_WAIT_V(8); PG8_WAIT_L(0); PG8_BAR; PG8_MMA(1, 0, At, B0); PG8_MMA(1, 1, At, B1); PG8_BAR; PG8_SCHED;
            PG8_LDB(B0, 1, 0); PG8_LDB(B1, 1, 1); PG8_SCHED; PG8_LDA(At, 1, 0); PG8_STAGE(PG8_SA(0, 1), a2 + hstep, voffA);
            PG8_WAIT_V(8); PG8_WAIT_L(0); PG8_BAR; PG8_MMA(0, 0, At, B0); PG8_MMA(0, 1, At, B1); PG8_BAR; PG8_SCHED;
            PG8_LDA(At, 1, 1); PG8_STAGE(PG8_SB(1, 0), b3, voffB); PG8_STAGE(PG8_SB(1, 1), b3 + hstepB, voffB); PG8_STAGE(PG8_SA(1, 0), a3, voffA);
            PG8_WAIT_V(8); PG8_WAIT_L(0); PG8_BAR; PG8_MMA(1, 0, At, B0); PG8_MMA(1, 1, At, B1); PG8_BAR; PG8_SCHED;
            } else {
            PG8_LDB(B0, 0, 0); PG8_SCHED; PG8_LDA(At, 0, 0); PG8_STAGE(PG8_SA(1, 1), a1 + hstep, voffA);
            PG8_WAIT_L(8); PG8_BAR; PG8_WAIT_L(0); PG8_MMA(0, 0, At, B0); PG8_BAR; PG8_SCHED;
            PG8_LDB(B1, 0, 1); PG8_STAGE(PG8_SB(0, 0), b2, voffB);
            PG8_BAR; PG8_WAIT_L(0); PG8_MMA(0, 1, At, B1); PG8_BAR;
            PG8_LDA(At, 0, 1); PG8_STAGE(PG8_SA(0, 0), a2, voffA);
            PG8_BAR; PG8_WAIT_L(0); PG8_MMA(1, 0, At, B0); PG8_BAR; PG8_SCHED;
            PG8_STAGE(PG8_SB(0, 1), b2 + hstepB, voffB);
            PG8_WAIT_V(6); PG8_BAR; PG8_MMA(1, 1, At, B1); PG8_BAR;
            PG8_LDB(B0, 1, 0); PG8_SCHED; PG8_LDA(At, 1, 0); PG8_STAGE(PG8_SA(0, 1), a2 + hstep, voffA);
            PG8_WAIT_L(8); PG8_BAR; PG8_WAIT_L(0); PG8_MMA(0, 0, At, B0); PG8_BAR; PG8_SCHED;
            PG8_LDB(B1, 1, 1); PG8_STAGE(PG8_SB(1, 0), b3, voffB);
            PG8_BAR; PG8_WAIT_L(0); PG8_MMA(0, 1, At, B1); PG8_BAR;
            PG8_LDA(At, 1, 1); PG8_STAGE(PG8_SA(1, 0), a3, voffA);
            PG8_BAR; PG8_WAIT_L(0); PG8_MMA(1, 0, At, B0); PG8_BAR; PG8_SCHED;
            PG8_STAGE(PG8_SB(1, 1), b3 + hstepB, voffB);
            PG8_WAIT_V(6); PG8_BAR; PG8_MMA(1, 1, At, B1); PG8_BAR;
            }
        }
        if constexpr (ALIGN_EPI) { if (wr == 0) PG8_BAR; }
        if constexpr (!Epi::AFTER_DRAIN) { const int l2_ = lane_id_v(); E(acc, cur, wr, wc, l2_ & 15, l2_ >> 4); S.done(cur); }
        if (!has_next) break;
#pragma unroll
        for (int a = 0; a < 2; ++a)
#pragma unroll
            for (int b = 0; b < 2; ++b)
#pragma unroll
                for (int m = 0; m < 4; ++m)
#pragma unroll
                    for (int n = 0; n < 2; ++n) acc[a][b][m][n] = (f32x4){0.f, 0.f, 0.f, 0.f};
        cur = nxt; cA = nA; cB = nB; ++ui;
        if constexpr (ALIGN_EPI) { if (wr == 1) PG8_BAR; }
    }
    PG8_WAIT_V(0);
    if constexpr (!ALIGN_EPI) { if (wr == 0) PG8_BAR; }
    PG8_BAR;
    if constexpr (Epi::AFTER_DRAIN) { E.fused(acc, cur, wr, wc, fr, fq, lds, wid, lane); S.done(cur); }
#undef PG8_SA
#undef PG8_SB
#undef PG8_STAGE
#undef PG8_LDA
#undef PG8_LDB
#undef PG8_MMA
#undef PG8_WAIT_V
#undef PG8_WAIT_L
#undef PG8_BAR
#undef PG8_SCHED
}
}
struct TDesc { int in_idx, in_off, g_idx, g_off; size_t ws_off; int K, ldw, N, row_off, mode, item0; };
constexpr int NTD = 28;
constexpr int TD_ITEMS = 23904;
constexpr int TD_P0 = 2048, TD_R0 = (TD_ITEMS + TD_P0) / 2;
__device__ const TDesc g_td[NTD] = {
    {10, 0, 7, 0, WS_WIN + (size_t)0 * 2, 1024, 1024, 1024, 0, 0, 0},
    {11, 0, 7, 0, WS_WIN + (size_t)0 * 2, 1024, 1024, 1024, 1024, 0, 512},
    {12, 0, 7, 0, WS_WIN + (size_t)0 * 2, 1024, 1024, 1024, 2048, 0, 1024},
    {13, 0, 7, 0, WS_WIN + (size_t)0 * 2, 1024, 1024, 1024, 3072, 0, 1536},
    {15, 0, 14, 0, WS_WHO + (size_t)0 * 2, 1024, 1024, 1024, 0, 0, 2048},
    {27, 0, 8, 0, WS_WUP + (size_t)0 * 2, 1024, 4096, 4096, 0, 0, 2560},
    {28, 0, -1, 0, WS_WDN + (size_t)0 * 2, 4096, 1024, 1024, 0, 0, 4608},
    {10, 1048576, 7, 1024, WS_WIN + (size_t)4194304 * 2, 1024, 1024, 1024, 0, 0, 6656},
    {11, 1048576, 7, 1024, WS_WIN + (size_t)4194304 * 2, 1024, 1024, 1024, 1024, 0, 7168},
    {12, 1048576, 7, 1024, WS_WIN + (size_t)4194304 * 2, 1024, 1024, 1024, 2048, 0, 7680},
    {13, 1048576, 7, 1024, WS_WIN + (size_t)4194304 * 2, 1024, 1024, 1024, 3072, 0, 8192},
    {15, 1048576, 14, 1024, WS_WHO + (size_t)1048576 * 2, 1024, 1024, 1024, 0, 0, 8704},
    {27, 4194304, 8, 1024, WS_WUP + (size_t)4194304 * 2, 1024, 4096, 4096, 0, 0, 9216},
    {28, 4194304, -1, 0, WS_WDN + (size_t)4194304 * 2, 4096, 1024, 1024, 0, 0, 11264},
    {18, 0, 17, 0, WS_WKVQ + (size_t)0 * 2, 1024, 256, 256, 0, 0, 13312},
    {20, 0, 17, 0, WS_WKVQ + (size_t)0 * 2, 1024, 64, 64, 256, 1, 13440},
    {23, 0, 7, 2048, WS_WKVQ + (size_t)0 * 2, 1024, 384, 384, 320, 0, 13472},
    {21, 0, 19, 0, WS_WUKV + (size_t)0 * 2, 256, 1024, 1024, 0, 0, 13664},
    {22, 0, 19, 0, WS_WUKV + (size_t)0 * 2, 256, 1024, 1024, 1024, 0, 13792},
    {25, 0, 24, 0, WS_WUQ + (size_t)0 * 2, 384, 1536, 1536, 0, 2, 13920},
    {26, 0, -1, 0, WS_WO + (size_t)0 * 2, 1024, 1024, 1024, 0, 0, 14208},
    {27, 8388608, 8, 2048, WS_WUP + (size_t)8388608 * 2, 1024, 4096, 4096, 0, 0, 14720},
    {28, 8388608, -1, 0, WS_WDN + (size_t)8388608 * 2, 4096, 1024, 1024, 0, 0, 16768},
    {23, 393216, 7, 3072, WS_WDQ1 + (size_t)0 * 2, 1024, 384, 384, 0, 0, 18816},
    {25, 589824, 24, 384, WS_WUQ + (size_t)589824 * 2, 384, 1536, 1536, 0, 2, 19008},
    {26, 1048576, -1, 0, WS_WO + (size_t)1048576 * 2, 1024, 1024, 1024, 0, 0, 19296},
    {27, 12582912, 8, 3072, WS_WUP + (size_t)12582912 * 2, 1024, 4096, 4096, 0, 0, 19808},
    {28, 12582912, -1, 0, WS_WDN + (size_t)12582912 * 2, 4096, 1024, 1024, 0, 0, 21856},
};
struct Args { const float* in[29]; float* out; unsigned char* ws; int ph_lo, ph_hi, flags, pad; };
struct Frame {
    LAS unsigned char* lds; int wave, G, bid;
    unsigned char* ws; float* out;
};
#define GAS __attribute__((address_space(1)))
template <class TT> __device__ __forceinline__ TT* wsp(unsigned char* ws, size_t off) { return (TT*)(ws + off); }
__device__ __forceinline__ float wave_sum(float v) { return xg_sum(row_sum16(v)); }
__device__ __forceinline__ int td_dest(int mode, int row_off, int n) {
    if (mode == 0) return row_off + n;
    if (mode == 1) return row_off + (n < 32 ? 2 * n : 2 * (n - 32) + 1);
    const int h = n / 192, d = n - h * 192;
    if (d < 128) return h * 128 + d;
    const int i = d - 128; return 1024 + h * 64 + (i < 32 ? 2 * i : 2 * (i - 32) + 1);
}
__device__ __forceinline__ void transpose_item(const float* __restrict__ W, const float* __restrict__ gain, bf16* WT, int K, int ldw, int N, int row_off, int mode, int item, LAS float* scr, int lane) {
    const int nblk = N / 32, kb = item / nblk, nb = item - kb * nblk, k0 = 64 * kb, n0 = 32 * nb;
#pragma unroll 8
    for (int i = 0; i < 32; ++i) { const int kk = 2 * i + (lane >> 5); float w = W[(size_t)(k0 + kk) * ldw + n0 + (lane & 31)]; if (gain) w *= gain[k0 + kk]; scr[kk * 33 + (lane & 31)] = w; }
    LDS_WAIT(); asm volatile("" ::: "memory");
    const int c = lane & 7;
#pragma unroll
    for (int j = 0; j < 4; ++j) { const int n = (lane >> 3) + 8 * j; const LAS float* s = scr + (8 * c) * 33 + n;
        v4u o; o.x = pk2(s[0 * 33], s[1 * 33]); o.y = pk2(s[2 * 33], s[3 * 33]); o.z = pk2(s[4 * 33], s[5 * 33]); o.w = pk2(s[6 * 33], s[7 * 33]);
        *(v4u*)(WT + (size_t)td_dest(mode, row_off, n0 + n) * K + k0 + 8 * c) = o; }
    LDS_WAIT(); asm volatile("" ::: "memory");
}
__device__ __forceinline__ const float* x_row(const Args& A, int r) { return r < MAIN ? A.in[0] + (size_t)r * D : (r - SIDE < NMETA ? A.in[6] + (size_t)(r - SIDE) * D : A.in[1] + (size_t)(r - SIDE - NMETA) * D); }
__device__ __forceinline__ void convert_weights(const Frame& F, const Args& A, int lo, int hi, int gw, int ngw, LAS float* scr, int lane) {
    for (int it = lo + gw; it < hi; it += ngw) {
        int id = 0;
#pragma unroll 1
        for (int k = 1; k < NTD; ++k) if (it >= g_td[k].item0) id = k;
        const TDesc d = g_td[id];
        const float* W = A.in[d.in_idx] + d.in_off; const float* gain = d.g_idx >= 0 ? A.in[d.g_idx] + d.g_off : nullptr;
        transpose_item(W, gain, (bf16*)(F.ws + d.ws_off), d.K, d.ldw, d.N, d.row_off, d.mode, it - d.item0, scr, lane);
    }
}
__device__ __forceinline__ void p0_prologue(const Frame& F, const Args& A) {
    int tid_ = F.wave * 64 + lane_id_v(); const int lane = tid_ & 63, wave = __builtin_amdgcn_readfirstlane(tid_ >> 6);
    LAS float* scr = (LAS float*)(F.lds + wave * 16384);
    const int gw = F.bid * 8 + wave, NGW = F.G * 8;
    convert_weights(F, A, 0, TD_P0, gw, NGW, scr, lane);
    const size_t gt = (size_t)F.bid * 512 + tid_, NGT = (size_t)F.G * 512;
    { v4u z = {0u, 0u, 0u, 0u};
      v4u* p0 = (v4u*)(F.ws + WS_WKVQ + (size_t)704 * 1024 * 2); for (size_t i = gt; i < (size_t)64 * 1024 * 2 / 16; i += NGT) p0[i] = z;
      v4u* p1 = (v4u*)(F.ws + WS_WDQ1 + (size_t)384 * 1024 * 2); for (size_t i = gt; i < (size_t)128 * 1024 * 2 / 16; i += NGT) p1[i] = z;
      v4u* p2 = (v4u*)(F.ws + WS_SSP + (size_t)MAIN * 64); for (size_t i = gt; i < (size_t)(NSS - 1) * MAIN * 64 / 16; i += NGT) p2[i] = z;
      v4u* p2s = (v4u*)(F.ws + WS_SSPS + (size_t)256 * 256); for (size_t i = gt; i < (size_t)(NSS - 1) * 256 * 256 / 16; i += NGT) p2s[i] = z;
      v4u* p3 = (v4u*)(F.ws + WS_OB + (size_t)(SIDE + NSIDE) * D * 2); for (size_t i = gt; i < (size_t)(256 - NSIDE) * D * 2 / 16; i += NGT) p3[i] = z;
      v4u* p4 = (v4u*)(F.ws + WS_AO + (size_t)(SIDE + NSIDE) * D * 2); for (size_t i = gt; i < (size_t)(256 - NSIDE) * D * 2 / 16; i += NGT) p4[i] = z; }
    { bf16* HB = wsp<bf16>(F.ws, WS_HB); float* ss0m = wsp<float>(F.ws, WS_SSP); float* ss0s = wsp<float>(F.ws, WS_SSPS);
      for (int r0 = gw; r0 < M; r0 += 4 * NGW) {
        f32x4 v[4][4];
#pragma unroll
        for (int i = 0; i < 4; ++i) { const int r = r0 + i * NGW; const float* src = nullptr;
            if (r < MAIN) src = A.in[0] + (size_t)r * D; else if (r - SIDE < NMETA) src = A.in[6] + (size_t)(r - SIDE) * D; else if (r - SIDE < NSIDE) src = A.in[1] + (size_t)(r - SIDE - NMETA) * D;
#pragma unroll
            for (int j = 0; j < 4; ++j) { v[i][j] = (f32x4){0.f, 0.f, 0.f, 0.f}; if (src) v[i][j] = *(const f32x4*)(src + 256 * j + 4 * lane); } }
#pragma unroll
        for (int i = 0; i < 4; ++i) { const int r = r0 + i * NGW; float s = 0.f;
            if (r < M) {
#pragma unroll
                for (int j = 0; j < 4; ++j) { const f32x4 x = v[i][j]; v2u w; w.x = pk2(x[0], x[1]); w.y = pk2(x[2], x[3]); *(v2u*)(HB + (size_t)r * D + 256 * j + 4 * lane) = w;
                    s += (x[0] * x[0] + x[1] * x[1]) + (x[2] * x[2] + x[3] * x[3]); }
                s = wave_sum(s); if (r < SIDE) { if (lane < 16) ss0m[(size_t)r * 16 + lane] = lane == 0 ? s : 0.f; } else ss0s[(size_t)(r - SIDE) * 64 + lane] = lane == 0 ? s : 0.f; } }
      } }
    { float* rope = wsp<float>(F.ws, WS_ROPE);
      for (size_t i = gt; i < (size_t)ROPE_SLOTS * 32; i += NGT) { const int slot = (int)(i >> 5), k = (int)(i & 31); const float pos = slot < LPROMPT ? (float)slot : (float)PAST;
        const float invf = (float)exp2(-(double)k * (13.287712379549449 / 32.0));
        const float ang = pos * invf; const double a = (double)ang; const double n = rint(a * 0.6366197723675814); const double r = fma(-n, 1.5707963267948966, a) - n * 6.123233995736766e-17;
        const float rf = (float)r; float sn = __sinf(rf), cs = __cosf(rf); const int q = ((int)n) & 3;
        float c2 = (q == 0) ? cs : (q == 1) ? -sn : (q == 2) ? -cs : sn; float s2 = (q == 0) ? sn : (q == 1) ? cs : (q == 2) ? -sn : -cs;
        rope[2 * i] = c2; rope[2 * i + 1] = s2; }
      float* lbt = wsp<float>(F.ws, WS_LBT); const float* lbw = A.in[16];
      for (size_t i = gt; i < 1024; i += NGT) { const float x0 = lbw[i], x1 = lbw[1024 + i]; const float lb1 = 1.f / (1.f + expf(x0 - x1));
        lbt[i] = 0.f; lbt[1024 + i] = logf(1e-30f); lbt[2048 + i] = 1.f;
        lbt[3072 + i] = log1pf(-lb1); lbt[3072 + 1024 + i] = logf(fmaxf(lb1, 1e-30f)); lbt[3072 + 2048 + i] = 1.f - lb1; } }
}
namespace epi {
using pg8::Unit;
typedef const f32x4 (&AccRef)[2][2][4][2];
__device__ __forceinline__ void st_bf4(bf16* p, f32x4 v) { v2u w; w.x = pk2(v[0], v[1]); w.y = pk2(v[2], v[3]); *(v2u*)p = w; }
__device__ __forceinline__ void st_bf8(bf16* p, f32x4 a, f32x4 b) { v4u w; w.x = pk2(a[0], a[1]); w.y = pk2(a[2], a[3]); w.z = pk2(b[0], b[1]); w.w = pk2(b[2], b[3]); *(v4u*)p = w; }
__device__ __forceinline__ unsigned dpp_ror8u(unsigned x) { return (unsigned)__builtin_amdgcn_update_dpp(0, (int)x, 0x128, 0xf, 0xf, false); }
__device__ __forceinline__ void st_lines(bf16* p, size_t stride, v4u W0, v4u W1, int fr) {
    const bool lo = fr < 8; v4u send, recv;
    send.x = lo ? W1.x : W0.x; send.y = lo ? W1.y : W0.y; send.z = lo ? W1.z : W0.z; send.w = lo ? W1.w : W0.w;
    recv.x = dpp_ror8u(send.x); recv.y = dpp_ror8u(send.y); recv.z = dpp_ror8u(send.z); recv.w = dpp_ror8u(send.w);
    v4u first, second;
    first.x = lo ? W0.x : recv.x; first.y = lo ? W0.y : recv.y; first.z = lo ? W0.z : recv.z; first.w = lo ? W0.w : recv.w;
    second.x = lo ? recv.x : W1.x; second.y = lo ? recv.y : W1.y; second.z = lo ? recv.z : W1.z; second.w = lo ? recv.w : W1.w;
    bf16* p0 = lo ? p : p - 8 * stride + 8; bf16* p1 = lo ? p + 8 * stride : p + 8;
    *(v4u*)p0 = first; *(v4u*)p1 = second;
}
__device__ __forceinline__ v4u pk8(f32x4 a, f32x4 b) { v4u w; w.x = pk2(a[0], a[1]); w.y = pk2(a[2], a[3]); w.z = pk2(b[0], b[1]); w.w = pk2(b[2], b[3]); return w; }
__device__ __forceinline__ float silu(float x) { return x * __builtin_amdgcn_rcpf(1.f + __expf(-x)); }
__device__ __forceinline__ float sumsq(f32x4 v) { return (v[0] * v[0] + v[1] * v[1]) + (v[2] * v[2] + v[3] * v[3]); }
__device__ __forceinline__ void row_ss_put(const SSW s, int row, float q, int fq, int slot) {
    q = xg_sum(q);
    if (fq == 0) { if (row < SIDE) s.m[(size_t)row * 16 + slot] = q; else s.s[(size_t)(row - SIDE) * 64 + slot] = q; }
}
__device__ __forceinline__ f32x4 rope4(const float* rope, int row, int i, f32x4 x) {
    const f32x4 cs = *(const f32x4*)(rope + ((size_t)pos_slot(row) * 32 + i) * 2);
    f32x4 y; y[0] = x[0] * cs[0] - x[1] * cs[1]; y[1] = x[1] * cs[0] + x[0] * cs[1]; y[2] = x[2] * cs[2] - x[3] * cs[3]; y[3] = x[3] * cs[2] + x[2] * cs[3]; return y;
}
template <class E> struct Big {
    static constexpr bool PERM = true, AFTER_DRAIN = false; E e;
    __device__ __forceinline__ void operator()(AccRef acc, const Unit& u, int wr, int wc, int fr, int fq) const {
        const int cb = u.pn * 256, c16 = cb + wc * 64 + fq * 16;
#pragma unroll
        for (int ai = 0; ai < 2; ++ai) {
            float rs[4]; f32x4 pre[4][2][2];
#pragma unroll
            for (int m = 0; m < 4; ++m) { const int row = u.pm * 256 + ai * 128 + wr * 64 + m * 16 + fr; rs[m] = e.row_begin(row);
#pragma unroll
                for (int bj = 0; bj < 2; ++bj) e.load8(row, c16 + 8 * bj, pre[m][bj][0], pre[m][bj][1]); }
#pragma unroll
            for (int m = 0; m < 4; ++m) { const int row = u.pm * 256 + ai * 128 + wr * 64 + m * 16 + fr; float q = 0.f;
                if constexpr (E::LINES) q = e.apply16(row, c16, cb, acc[ai][0][m][0], acc[ai][0][m][1], acc[ai][1][m][0], acc[ai][1][m][1], rs[m], pre[m][0][0], pre[m][0][1], pre[m][1][0], pre[m][1][1], fr);
                else {
#pragma unroll
                    for (int bj = 0; bj < 2; ++bj) q += e.apply8(row, c16 + 8 * bj, cb, acc[ai][bj][m][0], acc[ai][bj][m][1], rs[m], pre[m][bj][0], pre[m][bj][1]); }
                e.row_end(row, q, fq, cb, u.pn * 4 + wc); }
            asm volatile("" ::: "memory");
        }
    }
};
struct HgIn {
    static constexpr bool LINES = true;
    SSR ss; bf16 *QB, *KB, *VB, *GB; float* LF; const float* lbt;
    __device__ __forceinline__ float row_begin(int row) const { return rstd_of(ss_get(ss, row), 1.f / D); }
    __device__ __forceinline__ f32x4 load(int, int) const { return (f32x4){0.f, 0.f, 0.f, 0.f}; }
    __device__ __forceinline__ float apply(int row, int col, int cb, f32x4 a, float rs, f32x4) const {
        const int kind = cb >> 10, c = col & (D - 1); const size_t o = (size_t)row * D + c; const f32x4 x = a * rs;
        if (kind == 0) { f32x4 y; y[0] = silu(x[0]); y[1] = silu(x[1]); y[2] = silu(x[2]); y[3] = silu(x[3]); st_bf4(QB + o, y); }
        else if (kind == 1) {
            const f32x4 L1 = *(const f32x4*)(lbt + c), L2 = *(const f32x4*)(lbt + D + c), OM = *(const f32x4*)(lbt + 2 * D + c);
            f32x4 lf, kk;
#pragma unroll
            for (int e = 0; e < 4; ++e) { const float z = x[e];
                const float ez = __expf(-fabsf(z)), r1 = __builtin_amdgcn_rcpf(1.f + ez);
                const float ls = fminf(z, 0.f) - __logf(1.f + ez);
                const float aa = L1[e] + ls, cc = L2[e], dd = fabsf(aa - cc);
                lf[e] = fmaxf(aa, cc) + (dd < 24.f ? __logf(1.f + __expf(-dd)) : 0.f);
                kk[e] = OM[e] * (z > 0.f ? ez : 1.f) * r1; }
            *(f32x4*)(LF + o) = lf; st_bf4(KB + o, kk); }
        else if (kind == 2) st_bf4(VB + o, x);
        else { f32x4 y; y[0] = silu(x[0]); y[1] = silu(x[1]); y[2] = silu(x[2]); y[3] = silu(x[3]); st_bf4(GB + o, y); }
        return 0.f;
    }
    __device__ __forceinline__ void load8(int, int, f32x4& p0, f32x4& p1) const { p0 = (f32x4){0.f, 0.f, 0.f, 0.f}; p1 = p0; }
    __device__ __forceinline__ float apply8(int row, int col, int cb, f32x4 a0, f32x4 a1, float rs, f32x4 p0, f32x4 p1) const {
        const int kind = cb >> 10, c = col & (D - 1); const size_t o = (size_t)row * D + c;
        if (kind == 1) { apply(row, col, cb, a0, rs, p0); apply(row, col + 4, cb, a1, rs, p1); return 0.f; }
        f32x4 x0 = a0 * rs, x1 = a1 * rs;
        if (kind != 2) {
#pragma unroll
            for (int e = 0; e < 4; ++e) { x0[e] = silu(x0[e]); x1[e] = silu(x1[e]); } }
        if (kind == 0) st_bf8(QB + o, x0, x1); else if (kind == 2) st_bf8(VB + o, x0, x1); else st_bf8(GB + o, x0, x1);
        return 0.f; }
    __device__ __forceinline__ float apply16(int row, int col, int cb, f32x4 a0, f32x4 a1, f32x4 a2, f32x4 a3, float rs, f32x4 p0, f32x4 p1, f32x4 p2, f32x4 p3, int fr) const {
        const int kind = cb >> 10, c = col & (D - 1); const size_t o = (size_t)row * D + c;
        if (kind == 1) { apply(row, col, cb, a0, rs, p0); apply(row, col + 4, cb, a1, rs, p1); apply(row, col + 8, cb, a2, rs, p2); apply(row, col + 12, cb, a3, rs, p3); return 0.f; }
        f32x4 x0 = a0 * rs, x1 = a1 * rs, x2 = a2 * rs, x3 = a3 * rs;
        if (kind != 2) {
#pragma unroll
            for (int e = 0; e < 4; ++e) { x0[e] = silu(x0[e]); x1[e] = silu(x1[e]); x2[e] = silu(x2[e]); x3[e] = silu(x3[e]); } }
        const v4u W0 = pk8(x0, x1), W1 = pk8(x2, x3);
        if (kind == 0) st_lines(QB + o, D, W0, W1, fr); else if (kind == 2) st_lines(VB + o, D, W0, W1, fr); else st_lines(GB + o, D, W0, W1, fr);
        return 0.f; }
    __device__ __forceinline__ void row_end(int, float, int, int, int) const {}
};
template <bool FIRST> struct ResT {
    static constexpr bool LINES = true;
    const float* Xin; bf16* HB; SSW ssn; int dry; const float* meta; const float* xs;
    __device__ __forceinline__ float row_begin(int) const { return 1.f; }
    __device__ __forceinline__ f32x4 load(int row, int col) const {
        if constexpr (FIRST) { const float* src = Xin + (size_t)row * D + col;
            if (row >= SIDE) src = (row - SIDE < NMETA ? meta + (size_t)(row - SIDE) * D : xs + (size_t)(row - SIDE - NMETA) * D) + col;
            return *(const f32x4*)src; }
        else { const v2u w = *(const v2u*)(HB + (size_t)row * D + col); return (f32x4){bflo(w.x), bfhi(w.x), bflo(w.y), bfhi(w.y)}; } }
    __device__ __forceinline__ float apply(int row, int col, int, f32x4 a, float, f32x4 pre) const { const size_t o = (size_t)row * D + col;
        const f32x4 h = pre + a; if (!dry) st_bf4(HB + o, h); return sumsq(h); }
    __device__ __forceinline__ void load8(int row, int col, f32x4& p0, f32x4& p1) const {
        if constexpr (FIRST) { p0 = load(row, col); p1 = load(row, col + 4); }
        else { const v4u w = *(const v4u*)(HB + (size_t)row * D + col); p0 = (f32x4){bflo(w.x), bfhi(w.x), bflo(w.y), bfhi(w.y)}; p1 = (f32x4){bflo(w.z), bfhi(w.z), bflo(w.w), bfhi(w.w)}; } }
    __device__ __forceinline__ float apply8(int row, int col, int, f32x4 a0, f32x4 a1, float, f32x4 p0, f32x4 p1) const { const f32x4 h0 = p0 + a0, h1 = p1 + a1;
        if (!dry) st_bf8(HB + (size_t)row * D + col, h0, h1); return sumsq(h0) + sumsq(h1); }
    __device__ __forceinline__ float apply16(int row, int col, int, f32x4 a0, f32x4 a1, f32x4 a2, f32x4 a3, float, f32x4 p0, f32x4 p1, f32x4 p2, f32x4 p3, int fr) const {
        const f32x4 h0 = p0 + a0, h1 = p1 + a1, h2 = p2 + a2, h3 = p3 + a3;
        if (!dry) st_lines(HB + (size_t)row * D + col, D, pk8(h0, h1), pk8(h2, h3), fr);
        return (sumsq(h0) + sumsq(h1)) + (sumsq(h2) + sumsq(h3)); }
    __device__ __forceinline__ void row_end(int row, float q, int fq, int, int slot) const { if (!dry) row_ss_put(ssn, row, q, fq, slot); }
};
struct Up {
    static constexpr bool LINES = true;
    SSR ss; bf16* HID;
    __device__ __forceinline__ float row_begin(int row) const { return rstd_of(ss_get(ss, row), 1.f / D); }
    __device__ __forceinline__ f32x4 load(int, int) const { return (f32x4){0.f, 0.f, 0.f, 0.f}; }
    __device__ __forceinline__ float apply(int row, int col, int, f32x4 a, float rs, f32x4) const { f32x4 x = a * rs;
#pragma unroll
        for (int e = 0; e < 4; ++e) { const float r = fmaxf(x[e], 0.f); x[e] = r * r; }
        st_bf4(HID + (size_t)row * FF + col, x); return 0.f; }
    __device__ __forceinline__ void load8(int, int, f32x4& p0, f32x4& p1) const { p0 = (f32x4){0.f, 0.f, 0.f, 0.f}; p1 = p0; }
    __device__ __forceinline__ float apply8(int row, int col, int, f32x4 a0, f32x4 a1, float rs, f32x4, f32x4) const { f32x4 x0 = a0 * rs, x1 = a1 * rs;
#pragma unroll
        for (int e = 0; e < 4; ++e) { const float r0 = fmaxf(x0[e], 0.f), r1 = fmaxf(x1[e], 0.f); x0[e] = r0 * r0; x1[e] = r1 * r1; }
        st_bf8(HID + (size_t)row * FF + col, x0, x1); return 0.f; }
    __device__ __forceinline__ float apply16(int row, int col, int, f32x4 a0, f32x4 a1, f32x4 a2, f32x4 a3, float rs, f32x4, f32x4, f32x4, f32x4, int fr) const {
        f32x4 x0 = a0 * rs, x1 = a1 * rs, x2 = a2 * rs, x3 = a3 * rs;
#pragma unroll
        for (int e = 0; e < 4; ++e) { const float r0 = fmaxf(x0[e], 0.f), r1 = fmaxf(x1[e], 0.f), r2 = fmaxf(x2[e], 0.f), r3 = fmaxf(x3[e], 0.f); x0[e] = r0 * r0; x1[e] = r1 * r1; x2[e] = r2 * r2; x3[e] = r3 * r3; }
        st_lines(HID + (size_t)row * FF + col, FF, pk8(x0, x1), pk8(x2, x3), fr); return 0.f; }
    __device__ __forceinline__ void row_end(int, float, int, int, int) const {}
};
struct KvQ {
    static constexpr bool LINES = false;
    SSR ss; float* CKVF; bf16* CKVB; float* KRF; bf16* KRB; bf16* CQB; SSW ss_ckv; SSW ss_cq; const float* rope;
    __device__ __forceinline__ float row_begin(int row) const { return rstd_of(ss_get(ss, row), 1.f / D); }
    __device__ __forceinline__ f32x4 load(int, int) const { return (f32x4){0.f, 0.f, 0.f, 0.f}; }
    __device__ __forceinline__ float apply(int row, int col, int, f32x4 a, float rs, f32x4) const {
        const f32x4 x = a * rs;
        if (col < KVL) { *(f32x4*)(CKVF + (size_t)row * KVL + col) = x; st_bf4(CKVB + (size_t)row * KVL + col, x); return sumsq(x); }
        if (col < KVL + ROPE) { const int jj = col - KVL, i = jj >> 1; const f32x4 y = rope4(rope, row, i, x);
            float* kf = KRF + (size_t)row * ROPE; kf[i] = y[0]; kf[32 + i] = y[1]; kf[i + 1] = y[2]; kf[33 + i] = y[3];
            st_bf4(KRB + (size_t)row * ROPE + jj, y); return 0.f; }
        if (col < KVL + ROPE + QL) { st_bf4(CQB + (size_t)row * QL + (col - KVL - ROPE), x); return sumsq(x); }
        return 0.f;
    }
    __device__ __forceinline__ void load8(int, int, f32x4& p0, f32x4& p1) const { p0 = (f32x4){0.f, 0.f, 0.f, 0.f}; p1 = p0; }
    __device__ __forceinline__ float apply8(int row, int col, int cb, f32x4 a0, f32x4 a1, float rs, f32x4 p0, f32x4 p1) const {
        if (col >= KVL + ROPE && col < KVL + ROPE + QL) { const f32x4 x0 = a0 * rs, x1 = a1 * rs; st_bf8(CQB + (size_t)row * QL + (col - KVL - ROPE), x0, x1); return sumsq(x0) + sumsq(x1); }
        return apply(row, col, cb, a0, rs, p0) + apply(row, col + 4, cb, a1, rs, p1); }
    __device__ __forceinline__ void row_end(int row, float q, int fq, int cb, int slot) const { if (cb < KVL) row_ss_put(ss_ckv, row, q, fq, row < SIDE ? (slot & 3) : slot); else row_ss_put(ss_cq, row, q, fq, row < SIDE ? slot - 4 : slot); }
};
struct Dq {
    static constexpr bool LINES = false;
    SSR ss; bf16* CQB; SSW ss_cq;
    __device__ __forceinline__ float row_begin(int row) const { return rstd_of(ss_get(ss, row), 1.f / D); }
    __device__ __forceinline__ f32x4 load(int, int) const { return (f32x4){0.f, 0.f, 0.f, 0.f}; }
    __device__ __forceinline__ float apply(int row, int col, int, f32x4 a, float rs, f32x4) const { const f32x4 x = a * rs; if (col < QL) { st_bf4(CQB + (size_t)row * QL + col, x); return sumsq(x); } return 0.f; }
    __device__ __forceinline__ void load8(int, int, f32x4& p0, f32x4& p1) const { p0 = (f32x4){0.f, 0.f, 0.f, 0.f}; p1 = p0; }
    __device__ __forceinline__ float apply8(int row, int col, int, f32x4 a0, f32x4 a1, float rs, f32x4, f32x4) const { const f32x4 x0 = a0 * rs, x1 = a1 * rs; if (col < QL) { st_bf8(CQB + (size_t)row * QL + col, x0, x1); return sumsq(x0) + sumsq(x1); } return 0.f; }
    __device__ __forceinline__ void row_end(int row, float q, int fq, int, int slot) const { row_ss_put(ss_cq, row, q, fq, slot); }
};
struct Uq {
    static constexpr bool LINES = false;
    SSR ss_cq; bf16* QN; bf16* QR; const float* rope;
    __device__ __forceinline__ float row_begin(int row) const { return rstd_of(ss_get(ss_cq, row), 1.f / QL); }
    __device__ __forceinline__ f32x4 load(int, int) const { return (f32x4){0.f, 0.f, 0.f, 0.f}; }
    __device__ __forceinline__ float apply(int row, int col, int cb, f32x4 a, float rs, f32x4) const {
        const f32x4 x = a * rs;
        if (cb < D) st_bf4(QN + (size_t)row * D + col, x);
        else { const int cc = col - D; st_bf4(QR + (size_t)row * 512 + cc, rope4(rope, row, (cc & 63) >> 1, x)); }
        return 0.f;
    }
    __device__ __forceinline__ void load8(int, int, f32x4& p0, f32x4& p1) const { p0 = (f32x4){0.f, 0.f, 0.f, 0.f}; p1 = p0; }
    __device__ __forceinline__ float apply8(int row, int col, int cb, f32x4 a0, f32x4 a1, float rs, f32x4, f32x4) const {
        const f32x4 x0 = a0 * rs, x1 = a1 * rs;
        if (cb < D) st_bf8(QN + (size_t)row * D + col, x0, x1);
        else { const int cc = col - D; st_bf8(QR + (size_t)row * 512 + cc, rope4(rope, row, (cc & 63) >> 1, x0), rope4(rope, row, ((cc + 4) & 63) >> 1, x1)); }
        return 0.f; }
    __device__ __forceinline__ void row_end(int, float, int, int, int) const {}
};
struct KvUp {
    static constexpr bool LINES = false;
    SSR ss_ckv; bf16* KN; bf16* VV;
    __device__ __forceinline__ float row_begin(int row) const { return rstd_of(ss_get(ss_ckv, row), 1.f / KVL); }
    __device__ __forceinline__ f32x4 load(int, int) const { return (f32x4){0.f, 0.f, 0.f, 0.f}; }
    __device__ __forceinline__ float apply(int row, int col, int cb, f32x4 a, float rs, f32x4) const { const f32x4 x = a * rs; if (cb < D) st_bf4(KN + (size_t)row * D + col, x); else st_bf4(VV + (size_t)row * D + (col - D), x); return 0.f; }
    __device__ __forceinline__ void load8(int, int, f32x4& p0, f32x4& p1) const { p0 = (f32x4){0.f, 0.f, 0.f, 0.f}; p1 = p0; }
    __device__ __forceinline__ float apply8(int row, int col, int cb, f32x4 a0, f32x4 a1, float rs, f32x4, f32x4) const { const f32x4 x0 = a0 * rs, x1 = a1 * rs; if (cb < D) st_bf8(KN + (size_t)row * D + col, x0, x1); else st_bf8(VV + (size_t)row * D + (col - D), x0, x1); return 0.f; }
    __device__ __forceinline__ void row_end(int, float, int, int, int) const {}
};

constexpr int SIDE_MT = NSIDE / 16;
template <class E> __device__ __forceinline__ void side_gemm(const Frame& F, const bf16* __restrict__ A, const bf16* __restrict__ Bt, int N, int K, const E& e) {
    const int tid = F.wave * 64 + lane_id_v(), w = __builtin_amdgcn_readfirstlane(tid >> 6), lane = tid & 63, g = lane >> 4, li = lane & 15;
    LAS f32x4* red = (LAS f32x4*)F.lds;
    const int nks = K / 32, ncg = N / 16;
    int nrp = (F.G * 16) / N; nrp = nrp < 1 ? 1 : (nrp > SIDE_MT ? SIDE_MT : nrp);
    for (int it = F.bid; it < ncg * nrp; it += F.G) {
        const int cg = it / nrp, rp = it - cg * nrp, m0 = (rp * SIDE_MT) / nrp, m1 = ((rp + 1) * SIDE_MT) / nrp;
        f32x4 acc[SIDE_MT];
#pragma unroll
        for (int mt = 0; mt < SIDE_MT; ++mt) acc[mt] = (f32x4){0.f, 0.f, 0.f, 0.f};
        const bf16* bp = Bt + (size_t)(cg * 16 + li) * K + 8 * g; const bf16* ap = A + (size_t)(SIDE + li) * K + 8 * g;
#pragma unroll 2
        for (int ks = w; ks < nks; ks += 8) {
            const bf16x8 bfr = *(const bf16x8*)(bp + 32 * ks); bf16x8 afr[SIDE_MT];
#pragma unroll
            for (int mt = 0; mt < SIDE_MT; ++mt) if (mt >= m0 && mt < m1) afr[mt] = *(const bf16x8*)(ap + (size_t)(16 * mt) * K + 32 * ks);
#pragma unroll
            for (int mt = 0; mt < SIDE_MT; ++mt) if (mt >= m0 && mt < m1) acc[mt] = mfma16(bfr, afr[mt], acc[mt]);
        }
#pragma unroll
        for (int mt = 0; mt < SIDE_MT; ++mt) if (mt >= m0 && mt < m1) red[(w * SIDE_MT + mt) * 64 + lane] = acc[mt];
        __syncthreads();
#pragma unroll 1
        for (int mt = m0 + w; mt < m1; mt += 8) {
            f32x4 s = red[mt * 64 + lane];
#pragma unroll
            for (int ww = 1; ww < 8; ++ww) s += red[(ww * SIDE_MT + mt) * 64 + lane];
            const int row = SIDE + 16 * mt + li, cb = cg * 16; const float rs = e.row_begin(row);
            const float q = e.apply(row, cb + 4 * g, cb, s, rs, e.load(row, cb + 4 * g)); e.row_end(row, q, g, cb, cg);
        }
        __syncthreads();
    }
}
}
constexpr int HG_RS = 288;
constexpr int HG_QT = 0, HG_KT = 32 * HG_RS, HG_VT = 2 * 32 * HG_RS, HG_GT = 3 * 32 * HG_RS, HG_OT = 4 * 32 * HG_RS, HG_EC = 5 * 32 * HG_RS, HG_WTOT = HG_EC + 512, HG_SSX = HG_WTOT + 8 * 128 * 4, HG_END = HG_SSX + 32 * 8 * 4;
#define HG_BAR() do { asm volatile("s_waitcnt lgkmcnt(0)" ::: "memory"); __builtin_amdgcn_s_barrier(); asm volatile("" ::: "memory"); } while (0)
struct HgRegs { v4u q, k, v, gt; f32x4 l0, l1; };
struct HgCtx { const bf16 *QB, *KB, *VB, *GB; const float* LF; bf16* OB; LAS unsigned char* lds; int tid, w, lane, g, li, st, skg, b, h; };
__device__ __forceinline__ int hg_row(const HgCtx& C, int c, int t) { return c == 0 ? SIDE + t : C.b * T + 32 * (c - 1) + t; }
__device__ __forceinline__ bool hg_live(const HgCtx& C, int c, int t) { return c > 0 ? true : (t < NMETA); }
__device__ __forceinline__ void hg_load(const HgCtx& C, HgRegs& R, int c) {
    const int tk = C.lane & 31; const size_t o = (size_t)hg_row(C, c, tk) * D + C.h * HK + 16 * C.w + 8 * (C.lane >> 5);
    R.q = (v4u){0u, 0u, 0u, 0u}; R.k = R.q; R.v = R.q; R.gt = R.q; R.l0 = (f32x4){0.f, 0.f, 0.f, 0.f}; R.l1 = R.l0;
    if (hg_live(C, c, tk)) { R.q = *(const v4u*)(C.QB + o); R.k = *(const v4u*)(C.KB + o); R.v = *(const v4u*)(C.VB + o); R.gt = *(const v4u*)(C.GB + o); R.l0 = *(const f32x4*)(C.LF + o); R.l1 = *(const f32x4*)(C.LF + o + 4); }
}
template <int CTRL, int RMASK> __device__ __forceinline__ float dpp_mv(float x) { return __builtin_bit_cast(float, __builtin_amdgcn_update_dpp(0, __builtin_bit_cast(int, x), CTRL, RMASK, 0xf, false)); }
__device__ __forceinline__ float scan32(float x) {
    x += dpp_mv<0x111, 0xf>(x); x += dpp_mv<0x112, 0xf>(x); x += dpp_mv<0x114, 0xf>(x); x += dpp_mv<0x118, 0xf>(x);
    x += dpp_mv<0x142, 0xa>(x); return x;
}
__device__ __forceinline__ void hg_store_out(const HgCtx& C, int c) {
    if (hg_live(C, c, C.st) && (c > 0 || C.b == 0)) *(v4u*)(C.OB + (size_t)hg_row(C, c, C.st) * D + C.h * HV + 8 * C.skg) = *(const LAS v4u*)(C.lds + HG_OT + C.st * HG_RS + C.skg * 16);
}
__device__ __forceinline__ void hg_chunk(const HgCtx& C, HgRegs& R, f32x4 (&S)[8], int c, int nch) {
    LAS unsigned char* Qt = C.lds + HG_QT; LAS unsigned char* Kt = C.lds + HG_KT; LAS unsigned char* Vt = C.lds + HG_VT; LAS unsigned char* Gt = C.lds + HG_GT; LAS unsigned char* Ot = C.lds + HG_OT;
    LAS float* eC = (LAS float*)(C.lds + HG_EC); LAS float* ssx = (LAS float*)(C.lds + HG_SSX);
    const int w = C.w, lane = C.lane, g = C.g, li = C.li;
    float x[8] = {R.l0[0], R.l0[1], R.l0[2], R.l0[3], R.l1[0], R.l1[1], R.l1[2], R.l1[3]};
#pragma unroll
    for (int e = 0; e < 8; ++e) x[e] = scan32(x[e]);
    HG_BAR();
    if (c > 0) hg_store_out(C, c - 1);
    { const int tk = lane & 31, cb = 16 * w + 8 * (lane >> 5);
      const unsigned qw[4] = {R.q.x, R.q.y, R.q.z, R.q.w}, kw[4] = {R.k.x, R.k.y, R.k.z, R.k.w}; unsigned oq[4], ok[4];
#pragma unroll
      for (int e = 0; e < 4; ++e) { const float e0 = __expf(x[2 * e]), e1 = __expf(x[2 * e + 1]), i0 = __expf(fminf(-x[2 * e], 80.f)), i1 = __expf(fminf(-x[2 * e + 1], 80.f));
          oq[e] = pk2(bflo(qw[e]) * e0, bfhi(qw[e]) * e1); ok[e] = pk2(bflo(kw[e]) * i0, bfhi(kw[e]) * i1);
          if (tk == 31) { eC[cb + 2 * e] = e0; eC[cb + 2 * e + 1] = e1; } }
      *(LAS v4u*)(Qt + tk * HG_RS + cb * 2) = (v4u){oq[0], oq[1], oq[2], oq[3]}; *(LAS v4u*)(Kt + tk * HG_RS + cb * 2) = (v4u){ok[0], ok[1], ok[2], ok[3]};
      *(LAS v4u*)(Vt + tk * HG_RS + cb * 2) = R.v; *(LAS v4u*)(Gt + tk * HG_RS + cb * 2) = R.gt; }
    HG_BAR();
    if (c + 2 < nch) hg_load(C, R, c + 2);
    const unsigned kr_ = (unsigned)(size_t)(Kt + li * HG_RS + 16 * g), qr_ = (unsigned)(size_t)(Qt + li * HG_RS + 16 * g), qa_ = (unsigned)(size_t)(Qt + li * HG_RS + 8 * g);
    const unsigned vp_ = (unsigned)(size_t)(Vt + (4 * g + (li >> 2)) * HG_RS + (16 * w + 4 * (li & 3)) * 2), kp_ = (unsigned)(size_t)(Kt + (4 * g + (li >> 2)) * HG_RS + (4 * (li & 3)) * 2);
    const unsigned ec_ = (unsigned)(size_t)((LAS unsigned char*)eC + 16 * g);
    bf16x8 k0[4], k1[4], q0[4], q1[4]; s16x4 vlo, vhi, al[4][2], ah[4][2], klo[8], khi[8]; f32x4 ecv[8];
#pragma unroll
    for (int ks = 0; ks < 4; ++ks) {
        asm volatile("ds_read_b128 %0, %1 offset:%2" : "=v"(k0[ks]) : "v"(kr_), "i"(64 * ks));
        asm volatile("ds_read_b128 %0, %1 offset:%2" : "=v"(k1[ks]) : "v"(kr_), "i"(16 * HG_RS + 64 * ks));
        asm volatile("ds_read_b128 %0, %1 offset:%2" : "=v"(q0[ks]) : "v"(qr_), "i"(64 * ks));
        asm volatile("ds_read_b128 %0, %1 offset:%2" : "=v"(q1[ks]) : "v"(qr_), "i"(16 * HG_RS + 64 * ks)); }
    asm volatile("ds_read_b64_tr_b16 %0, %1 offset:%2" : "=v"(vlo) : "v"(vp_), "i"(0));
    asm volatile("ds_read_b64_tr_b16 %0, %1 offset:%2" : "=v"(vhi) : "v"(vp_), "i"(16 * HG_RS));
#pragma unroll
    for (int ks = 0; ks < 4; ++ks) {
        asm volatile("ds_read_b64 %0, %1 offset:%2" : "=v"(al[ks][0]) : "v"(qa_), "i"(64 * ks));
        asm volatile("ds_read_b64 %0, %1 offset:%2" : "=v"(al[ks][1]) : "v"(qa_), "i"(64 * ks + 32));
        asm volatile("ds_read_b64 %0, %1 offset:%2" : "=v"(ah[ks][0]) : "v"(qa_), "i"(16 * HG_RS + 64 * ks));
        asm volatile("ds_read_b64 %0, %1 offset:%2" : "=v"(ah[ks][1]) : "v"(qa_), "i"(16 * HG_RS + 64 * ks + 32)); }
    asm volatile("s_waitcnt lgkmcnt(15)" : "+v"(k0[0]), "+v"(k0[1]), "+v"(k0[2]), "+v"(k0[3]), "+v"(k1[0]), "+v"(k1[1]), "+v"(k1[2]), "+v"(k1[3]), "+v"(q0[0]), "+v"(q0[1]), "+v"(q0[2]), "+v"(q0[3]), "+v"(q1[0]), "+v"(q1[1]), "+v"(q1[2]), "+v"(q1[3]), "+v"(vlo), "+v"(vhi));
    f32x4 d00 = {0.f, 0.f, 0.f, 0.f}, d01 = d00, d11 = d00;
#pragma unroll
    for (int ks = 0; ks < 4; ++ks) { d00 = mfma16(k0[ks], q0[ks], d00); d01 = mfma16(k0[ks], q1[ks], d01); d11 = mfma16(k1[ks], q1[ks], d11); }
#pragma unroll
    for (int r = 0; r < 4; ++r) { if (4 * g + r > li) { d00[r] = 0.f; d11[r] = 0.f; } }
    const bf16x8 p0 = pack8(d00, (f32x4){0.f, 0.f, 0.f, 0.f}), p1 = pack8(d01, d11);
    const bf16x8 vf = cat4(vlo, vhi);
    f32x4 o0 = mfma16(p0, vf, (f32x4){0.f, 0.f, 0.f, 0.f}), o1 = mfma16(p1, vf, (f32x4){0.f, 0.f, 0.f, 0.f});
    asm volatile("s_waitcnt lgkmcnt(0)" : "+v"(al[0][0]), "+v"(al[0][1]), "+v"(al[1][0]), "+v"(al[1][1]), "+v"(al[2][0]), "+v"(al[2][1]), "+v"(al[3][0]), "+v"(al[3][1]), "+v"(ah[0][0]), "+v"(ah[0][1]), "+v"(ah[1][0]), "+v"(ah[1][1]), "+v"(ah[2][0]), "+v"(ah[2][1]), "+v"(ah[3][0]), "+v"(ah[3][1]));
#define HG_RD3(kb_) do { asm volatile("ds_read_b64_tr_b16 %0, %1 offset:%2" : "=v"(klo[kb_]) : "v"(kp_), "i"(32 * (kb_))); \
        asm volatile("ds_read_b64_tr_b16 %0, %1 offset:%2" : "=v"(khi[kb_]) : "v"(kp_), "i"(16 * HG_RS + 32 * (kb_))); \
        asm volatile("ds_read_b128 %0, %1 offset:%2" : "=v"(ecv[kb_]) : "v"(ec_), "i"(64 * (kb_))); } while (0)
    HG_RD3(0); HG_RD3(1); HG_RD3(2); HG_RD3(3);
#pragma unroll
    for (int ks = 0; ks < 4; ++ks) {
        const bf16x8 sb = pack8(S[2 * ks], S[2 * ks + 1]);
        o0 = mfma16(cat4(al[ks][0], al[ks][1]), sb, o0); o1 = mfma16(cat4(ah[ks][0], ah[ks][1]), sb, o1);
    }
    HG_RD3(4); HG_RD3(5); HG_RD3(6); HG_RD3(7);
#undef HG_RD3
    asm volatile("s_waitcnt lgkmcnt(12)" : "+v"(klo[0]), "+v"(klo[1]), "+v"(klo[2]), "+v"(klo[3]), "+v"(khi[0]), "+v"(khi[1]), "+v"(khi[2]), "+v"(khi[3]), "+v"(ecv[0]), "+v"(ecv[1]), "+v"(ecv[2]), "+v"(ecv[3]));
#pragma unroll
    for (int kb = 0; kb < 4; ++kb) S[kb] = mfma16(cat4(klo[kb], khi[kb]), vf, S[kb]) * ecv[kb];
    asm volatile("s_waitcnt lgkmcnt(0)" : "+v"(klo[4]), "+v"(klo[5]), "+v"(klo[6]), "+v"(klo[7]), "+v"(khi[4]), "+v"(khi[5]), "+v"(khi[6]), "+v"(khi[7]), "+v"(ecv[4]), "+v"(ecv[5]), "+v"(ecv[6]), "+v"(ecv[7]));
#pragma unroll
    for (int kb = 4; kb < 8; ++kb) S[kb] = mfma16(cat4(klo[kb], khi[kb]), vf, S[kb]) * ecv[kb];
    float q2[8];
#pragma unroll
    for (int r = 0; r < 4; ++r) { q2[r] = o0[r] * o0[r]; q2[4 + r] = o1[r] * o1[r]; }
#pragma unroll
    for (int e = 0; e < 8; ++e) q2[e] = row_sum16(q2[e]);
    if (li == 0) {
#pragma unroll
        for (int r = 0; r < 4; ++r) { ssx[(4 * g + r) * 8 + w] = q2[r]; ssx[(16 + 4 * g + r) * 8 + w] = q2[4 + r]; } }
    HG_BAR();
#pragma unroll
    for (int tb = 0; tb < 2; ++tb)
#pragma unroll
        for (int r = 0; r < 4; ++r) { const int t = 16 * tb + 4 * g + r; const f32x4 s0 = *(const LAS f32x4*)(ssx + t * 8), s1 = *(const LAS f32x4*)(ssx + t * 8 + 4);
            const float rs = rstd_of((s0[0] + s0[1]) + (s0[2] + s0[3]) + (s1[0] + s1[1]) + (s1[2] + s1[3]), 1.f / HV);
            const float gv = bf2f(*(const LAS bf16*)(Gt + t * HG_RS + (16 * w + li) * 2));
            *(LAS bf16*)(Ot + t * HG_RS + (16 * w + li) * 2) = (bf16)f2bf((tb == 0 ? o0[r] : o1[r]) * rs * gv); }
}
__device__ __forceinline__ void hg_prompt_unit(const Frame& F, int l, int u) {
    HgCtx C; C.tid = F.wave * 64 + lane_id_v(); C.w = __builtin_amdgcn_readfirstlane(C.tid >> 6); C.lane = C.tid & 63; C.g = C.lane >> 4; C.li = C.lane & 15; C.st = C.tid >> 4; C.skg = C.tid & 15;
    C.b = u >> 3; C.h = u & 7; C.lds = F.lds;
    C.QB = wsp<bf16>(F.ws, WS_QB); C.KB = wsp<bf16>(F.ws, WS_KB); C.VB = wsp<bf16>(F.ws, WS_VB); C.GB = wsp<bf16>(F.ws, WS_GB); C.LF = wsp<float>(F.ws, WS_LF); C.OB = wsp<bf16>(F.ws, WS_OB);
    f32x4 S[8];
#pragma unroll
    for (int kb = 0; kb < 8; ++kb) S[kb] = (f32x4){0.f, 0.f, 0.f, 0.f};
    constexpr int NCH = 1 + T / 32;
    HgRegs RA, RB; hg_load(C, RA, 0); hg_load(C, RB, 1);
#pragma unroll 1
    for (int c = 0; c < NCH; c += 2) { hg_chunk(C, RA, S, c, NCH); if (c + 1 < NCH) hg_chunk(C, RB, S, c + 1, NCH); }
    HG_BAR();
    hg_store_out(C, NCH - 1);
    float* so = F.out + O_SP + ((size_t)(l * NB + C.b) * HH + C.h) * HK * HV;
#pragma unroll
    for (int kb = 0; kb < 8; ++kb)
#pragma unroll
        for (int r = 0; r < 4; ++r) so[(size_t)(16 * kb + 4 * C.g + r) * HV + 16 * C.w + C.li] = S[kb][r];
    __syncthreads();
}
__device__ __forceinline__ void hg_sample_unit(const Frame& F, const float* state_in, int l, int u) {
    int tid_ = F.wave * 64 + lane_id_v(); const int tid = tid_, w = __builtin_amdgcn_readfirstlane(tid >> 6), lane = tid & 63, hw = lane >> 5, l32 = lane & 31;
    const int bs = u >> 3, h = u & 7; const int row = SIDE + NMETA + bs;
    const bf16* QB = wsp<bf16>(F.ws, WS_QB); const bf16* KB = wsp<bf16>(F.ws, WS_KB); const bf16* VB = wsp<bf16>(F.ws, WS_VB); const bf16* GB = wsp<bf16>(F.ws, WS_GB);
    const float* LF = wsp<float>(F.ws, WS_LF); bf16* OB = wsp<bf16>(F.ws, WS_OB);
    LAS float* part = (LAS float*)F.lds;
    const size_t so = ((size_t)(l * NS + bs) * HH + h) * HK * HV; const float* s0 = state_in + so; float* s1 = F.out + O_SS + so;
    const size_t ro = (size_t)row * D + h * HK;
    const v2u vv = *(const v2u*)(VB + ro + 4 * l32); const f32x4 v4 = {bflo(vv.x), bfhi(vv.x), bflo(vv.y), bfhi(vv.y)};
    f32x4 st[8]; float fv[8], kv[8], qv[8];
#pragma unroll
    for (int i = 0; i < 8; ++i) { const int k = 16 * w + 2 * i + hw; st[i] = *(const f32x4*)(s0 + (size_t)k * HV + 4 * l32); fv[i] = LF[ro + k]; kv[i] = bf2f(KB[ro + k]); qv[i] = bf2f(QB[ro + k]); }
    f32x4 o = {0.f, 0.f, 0.f, 0.f};
#pragma unroll
    for (int i = 0; i < 8; ++i) { const int k = 16 * w + 2 * i + hw; const f32x4 a = st[i] * __expf(fv[i]) + v4 * kv[i]; *(f32x4*)(s1 + (size_t)k * HV + 4 * l32) = a; o += a * qv[i]; }
#pragma unroll
    for (int e = 0; e < 4; ++e) o[e] = half_sum(o[e]);
    if (hw == 0) *(LAS f32x4*)(part + w * 128 + 4 * l32) = o;
    HG_BAR();
    float s = 0.f;
    if (tid < 128) {
#pragma unroll
        for (int ww = 0; ww < 8; ++ww) s += part[ww * 128 + tid];
        const float q = wave_sum(s * s); if (lane == 0) part[1024 + w] = q; }
    HG_BAR();
    if (tid < 128) { const float rs = rstd_of(part[1024] + part[1025], 1.f / HV); OB[ro + tid] = (bf16)f2bf(s * rs * bf2f(GB[ro + tid])); }
    HG_BAR();
}
__device__ __forceinline__ void kv_outputs(const Frame& F, const float* kv_gain) {
    const float* CKVF = wsp<float>(F.ws, WS_CKVF); const float* KRF = wsp<float>(F.ws, WS_KRF); const SSR ssc{wsp<float>(F.ws, WS_SSP) + (size_t)SS_CKV * MAIN * 16, wsp<float>(F.ws, WS_SSPS) + (size_t)SS_CKV * 256 * 64};
    int tid_ = F.wave * 64 + lane_id_v(); const int lane = tid_ & 63, gw = F.bid * 8 + __builtin_amdgcn_readfirstlane(tid_ >> 6), NGW = F.G * 8; const f32x4 g4 = *(const f32x4*)(kv_gain + 4 * lane);
    for (int i = gw; i < NB * LPROMPT + NS; i += NGW) {
        int src; float* oc; float* ok;
        if (i < NB * LPROMPT) { const int b = i / LPROMPT, p = i - b * LPROMPT; src = p < NMETA ? SIDE + p : b * T + p - NMETA; oc = F.out + O_CKVP + (size_t)i * KVL; ok = F.out + O_KRP + (size_t)i * ROPE; }
        else { const int bs = i - NB * LPROMPT; src = SIDE + NMETA + bs; oc = F.out + O_CKVS + (size_t)bs * KVL; ok = F.out + O_KRS + (size_t)bs * ROPE; }
        const float rs = rstd_of(ss_get(ssc, src), 1.f / KVL); const f32x4 x = *(const f32x4*)(CKVF + (size_t)src * KVL + 4 * lane);
        *(f32x4*)(oc + 4 * lane) = x * rs * g4; ok[lane] = KRF[(size_t)src * ROPE + lane];
    }
}
__device__ __forceinline__ void final_norm(const Frame& F, const float* gain) {
    const bf16* HB = wsp<bf16>(F.ws, WS_HB); const SSR ss{wsp<float>(F.ws, WS_SSP) + (size_t)8 * MAIN * 16, wsp<float>(F.ws, WS_SSPS) + (size_t)8 * 256 * 64};
    int tid_ = F.wave * 64 + lane_id_v(); const int lane = tid_ & 63, gw = F.bid * 8 + __builtin_amdgcn_readfirstlane(tid_ >> 6), NGW = F.G * 8;
    for (int i = gw; i < MAIN + NS; i += NGW) {
        const int r = i < MAIN ? i : SIDE + NMETA + (i - MAIN); float* o = i < MAIN ? F.out + O_Y + (size_t)i * D : F.out + O_YS + (size_t)(i - MAIN) * D;
        const float rs = rstd_of(ss_get(ss, r), 1.f / D);
#pragma unroll
        for (int j = 0; j < 4; ++j) { const int c = 256 * j + 4 * lane; const v2u w = *(const v2u*)(HB + (size_t)r * D + c);
            *(f32x4*)(o + c) = (f32x4){bflo(w.x), bfhi(w.x), bflo(w.y), bfhi(w.y)} * rs * *(const f32x4*)(gain + c); }
    }
}
constexpr int P_KS = 400, P_VS = 288, P_VOFF = 64 * P_KS, P_BUF = P_VOFF + 64 * P_VS;
#define ATT_BAR() do { asm volatile("s_waitcnt lgkmcnt(0)" ::: "memory"); __builtin_amdgcn_s_barrier(); asm volatile("" ::: "memory"); } while (0)
struct AttnUnit { int b, h, qb, meta; };
__device__ __forceinline__ void prefill_tile(LAS unsigned char* Kt, LAS unsigned char* Vt, const bf16x8 (&qf)[2][6], f32x4 (&o)[2][8], float (&mrun)[2], float (&lrun)[2], int t, int tq0, int li, int g, const AttnUnit U) {
        const int k0 = 64 * (t - 1);
        if (t == 0 || k0 <= tq0 + 31) {
            f32x4 st[2][4];
#pragma unroll
            for (int nq = 0; nq < 2; ++nq)
#pragma unroll
                for (int kb = 0; kb < 4; ++kb) st[nq][kb] = (f32x4){0.f, 0.f, 0.f, 0.f};
            { const unsigned ka_ = (unsigned)(size_t)(Kt + li * P_KS + 16 * g); bf16x8 kA[3], kB[3];
#define P_RD3(K_, kb_, hf_) do { _Pragma("unroll") for (int s = 0; s < 3; ++s) asm volatile("ds_read_b128 %0, %1 offset:%2" : "=v"(K_[s]) : "v"(ka_), "i"((kb_) * 16 * P_KS + 64 * (3 * (hf_) + s))); } while (0)
#define P_WT3(K_, n_) asm volatile("s_waitcnt lgkmcnt(" #n_ ")" : "+v"(K_[0]), "+v"(K_[1]), "+v"(K_[2]))
#define P_MM3(K_, kb_, hf_) do { _Pragma("unroll") for (int s = 0; s < 3; ++s) { st[0][kb_] = mfma16(K_[s], qf[0][3 * (hf_) + s], st[0][kb_]); st[1][kb_] = mfma16(K_[s], qf[1][3 * (hf_) + s], st[1][kb_]); } } while (0)
              P_RD3(kA, 0, 0);
              P_RD3(kB, 0, 1); P_WT3(kA, 3); P_MM3(kA, 0, 0);
              P_RD3(kA, 1, 0); P_WT3(kB, 3); P_MM3(kB, 0, 1);
              P_RD3(kB, 1, 1); P_WT3(kA, 3); P_MM3(kA, 1, 0);
              P_RD3(kA, 2, 0); P_WT3(kB, 3); P_MM3(kB, 1, 1);
              P_RD3(kB, 2, 1); P_WT3(kA, 3); P_MM3(kA, 2, 0);
              P_RD3(kA, 3, 0); P_WT3(kB, 3); P_MM3(kB, 2, 1);
              P_RD3(kB, 3, 1); P_WT3(kA, 3); P_MM3(kA, 3, 0);
              P_WT3(kB, 0); P_MM3(kB, 3, 1);
#undef P_RD3
#undef P_WT3
#undef P_MM3
            }
            bf16x8 pf[2][2];
#pragma unroll
            for (int nq = 0; nq < 2; ++nq) {
                const int tq = tq0 + 16 * nq + li;
                if (t == 0) {
#pragma unroll
                    for (int kb = 0; kb < 4; ++kb)
#pragma unroll
                        for (int r = 0; r < 4; ++r) { const int key = 16 * kb + 4 * g + r; if (key >= NMETA || (U.meta && key > li)) st[nq][kb][r] = NEG; }
                } else if (k0 + 63 > tq0) {
#pragma unroll
                    for (int kb = 0; kb < 4; ++kb)
#pragma unroll
                        for (int r = 0; r < 4; ++r) { const int key = k0 + 16 * kb + 4 * g + r; if (key > tq) st[nq][kb][r] = NEG; }
                }
                float mx = fmaxf(fmaxf(max4(st[nq][0]), max4(st[nq][1])), fmaxf(max4(st[nq][2]), max4(st[nq][3])));
                mx = xg_max(mx);
                if (__builtin_amdgcn_ballot_w64(mx > mrun[nq]) != 0ull) {
                    const float mnew = fmaxf(mrun[nq], mx), alpha = __builtin_amdgcn_exp2f((mrun[nq] - mnew) * ATT_C); mrun[nq] = mnew; lrun[nq] *= alpha;
#pragma unroll
                    for (int vb = 0; vb < 8; ++vb) o[nq][vb] = o[nq][vb] * alpha;
                }
                const float mc = -mrun[nq] * ATT_C; float rs = 0.f;
#pragma unroll
                for (int kb = 0; kb < 4; ++kb)
#pragma unroll
                    for (int r = 0; r < 4; ++r) { const float p = __builtin_amdgcn_exp2f(fmaf(st[nq][kb][r], ATT_C, mc)); st[nq][kb][r] = p; rs += p; }
                lrun[nq] += xg_sum(rs);
                pf[nq][0] = pack8(st[nq][0], st[nq][1]); pf[nq][1] = pack8(st[nq][2], st[nq][3]);
            }
            { const unsigned va_ = (unsigned)(size_t)(Vt + (4 * g + (li >> 2)) * P_VS + (4 * (li & 3)) * 2); s16x4 vA[4], vB[4];
#define P_RD4(V_, k32_, q_) do { _Pragma("unroll") for (int i = 0; i < 2; ++i) { \
                  asm volatile("ds_read_b64_tr_b16 %0, %1 offset:%2" : "=v"(V_[2 * i]) : "v"(va_), "i"((32 * (k32_)) * P_VS + 32 * (2 * (q_) + i))); \
                  asm volatile("ds_read_b64_tr_b16 %0, %1 offset:%2" : "=v"(V_[2 * i + 1]) : "v"(va_), "i"((32 * (k32_) + 16) * P_VS + 32 * (2 * (q_) + i))); } } while (0)
#define P_WT4(V_, n_) asm volatile("s_waitcnt lgkmcnt(" #n_ ")" : "+v"(V_[0]), "+v"(V_[1]), "+v"(V_[2]), "+v"(V_[3]))
#define P_MM4(V_, k32_, q_) do { _Pragma("unroll") for (int i = 0; i < 2; ++i) { const bf16x8 a = cat4(V_[2 * i], V_[2 * i + 1]); \
                  o[0][2 * (q_) + i] = mfma16(a, pf[0][k32_], o[0][2 * (q_) + i]); o[1][2 * (q_) + i] = mfma16(a, pf[1][k32_], o[1][2 * (q_) + i]); } } while (0)
              P_RD4(vA, 0, 0);
              P_RD4(vB, 0, 1); P_WT4(vA, 4); P_MM4(vA, 0, 0);
              P_RD4(vA, 0, 2); P_WT4(vB, 4); P_MM4(vB, 0, 1);
              P_RD4(vB, 0, 3); P_WT4(vA, 4); P_MM4(vA, 0, 2);
              P_RD4(vA, 1, 0); P_WT4(vB, 4); P_MM4(vB, 0, 3);
              P_RD4(vB, 1, 1); P_WT4(vA, 4); P_MM4(vA, 1, 0);
              P_RD4(vA, 1, 2); P_WT4(vB, 4); P_MM4(vB, 1, 1);
              P_RD4(vB, 1, 3); P_WT4(vA, 4); P_MM4(vA, 1, 2);
              P_WT4(vB, 0); P_MM4(vB, 1, 3);
#undef P_RD4
#undef P_WT4
#undef P_MM4
            }
        }
}
__device__ __forceinline__ void attn_prefill_unit(const Frame& F, const AttnUnit U) {
    const bf16* QN = wsp<bf16>(F.ws, WS_QN); const bf16* QR = wsp<bf16>(F.ws, WS_QR); const bf16* KN = wsp<bf16>(F.ws, WS_KN); const bf16* VV = wsp<bf16>(F.ws, WS_VV);
    const bf16* KRB = wsp<bf16>(F.ws, WS_KRB); bf16* AO = wsp<bf16>(F.ws, WS_AO);
    int tid_ = F.wave * 64 + lane_id_v(); const int tid = tid_, w = __builtin_amdgcn_readfirstlane(tid >> 6), lane = tid & 63, g = lane >> 4, li = lane & 15, h = U.h;
    const int tq0 = U.qb * 256 + 32 * w;
    const int rowq0 = U.meta ? SIDE + 32 * w : U.b * T + tq0;
    const int ntiles = U.meta ? 1 : 1 + 4 * (U.qb + 1);
    bf16x8 qf[2][6];
#pragma unroll
    for (int nq = 0; nq < 2; ++nq) { const size_t row = (size_t)(rowq0 + 16 * nq + li);
#pragma unroll
        for (int s = 0; s < 6; ++s) qf[nq][s] = s < 4 ? *(const bf16x8*)(QN + row * D + h * NOPE + 32 * s + 8 * g) : *(const bf16x8*)(QR + row * 512 + h * ROPE + 32 * (s - 4) + 8 * g); }
    f32x4 o[2][8]; float mrun[2], lrun[2];
#pragma unroll
    for (int nq = 0; nq < 2; ++nq) { mrun[nq] = NEG; lrun[nq] = 0.f;
#pragma unroll
        for (int vb = 0; vb < 8; ++vb) o[nq][vb] = (f32x4){0.f, 0.f, 0.f, 0.f}; }
    v4u kreg[3], vreg[2];
#define P_LOAD_TILE(t_) do { const int keyrow0_ = (t_) == 0 ? SIDE : U.b * T + 64 * ((t_) - 1); \
        _Pragma("unroll") for (int j = 0; j < 3; ++j) { const int c = tid + 512 * j, key = c / 24, ch = c - key * 24; const size_t kr = (size_t)(keyrow0_ + key); \
            kreg[j] = ch < 16 ? *(const v4u*)(KN + kr * D + h * NOPE + 8 * ch) : *(const v4u*)(KRB + kr * ROPE + 8 * (ch - 16)); } \
        _Pragma("unroll") for (int j = 0; j < 2; ++j) { const int c = tid + 512 * j, key = c >> 4, ch = c & 15; vreg[j] = *(const v4u*)(VV + (size_t)(keyrow0_ + key) * D + h * VD + 8 * ch); } } while (0)
#define P_STORE_TILE(buf_) do { LAS unsigned char* kt_ = F.lds + (buf_) * P_BUF; LAS unsigned char* vt_ = kt_ + P_VOFF; \
        _Pragma("unroll") for (int j = 0; j < 3; ++j) { const int c = tid + 512 * j, key = c / 24, ch = c - key * 24; *(LAS v4u*)(kt_ + key * P_KS + ch * 16) = kreg[j]; } \
        _Pragma("unroll") for (int j = 0; j < 2; ++j) { const int c = tid + 512 * j, key = c >> 4, ch = c & 15; *(LAS v4u*)(vt_ + key * P_VS + ch * 16) = vreg[j]; } } while (0)
    P_LOAD_TILE(0); P_STORE_TILE(0); ATT_BAR();
#pragma unroll 1
    for (int t = 0; t < ntiles; ++t) {
        LAS unsigned char* Kt = F.lds + (t & 1) * P_BUF;
        if (t + 1 < ntiles) P_LOAD_TILE(t + 1);
        prefill_tile(Kt, Kt + P_VOFF, qf, o, mrun, lrun, t, tq0, li, g, U);
        if (t + 1 < ntiles) P_STORE_TILE((t + 1) & 1);
        ATT_BAR();
    }
#undef P_LOAD_TILE
#undef P_STORE_TILE
#pragma unroll
    for (int nq = 0; nq < 2; ++nq) {
        if (!U.meta || (w == 0 && nq == 0)) { const float inv = 1.f / lrun[nq]; const size_t row = (size_t)(rowq0 + 16 * nq + li);
#pragma unroll
            for (int vb = 0; vb < 8; ++vb) { const f32x4 v = o[nq][vb] * inv; v2u wv; wv.x = pk2(v[0], v[1]); wv.y = pk2(v[2], v[3]); *(v2u*)(AO + row * D + h * VD + 16 * vb + 4 * g) = wv; } }
    }
    __syncthreads();
}

constexpr int D_KS = 672, D_KT = 64 * D_KS, D_QOFF = 2 * D_KT;
struct DRegs { f32x4 c[8], r[2]; };
constexpr int NSPLIT = 2, PART_STRIDE = 2112;
__device__ __forceinline__ void attn_decode_unit(const Frame& F, const Args& A, int bs, int sp) {
    const bf16* QN = wsp<bf16>(F.ws, WS_QN); const bf16* QR = wsp<bf16>(F.ws, WS_QR);
    const float* CKVF = wsp<float>(F.ws, WS_CKVF); const float* KRF = wsp<float>(F.ws, WS_KRF); const SSR ssc{wsp<float>(F.ws, WS_SSP) + (size_t)SS_CKV * MAIN * 16, wsp<float>(F.ws, WS_SSPS) + (size_t)SS_CKV * 256 * 64};
    const char* cache_ckv = (const char*)A.in[3]; const char* cache_kr = (const char*)A.in[4]; const float* w_uk = A.in[21]; const float* kv_gain = A.in[19];
    const int* ptab = (const int*)A.in[5] + ((AFLAGS & 64) ? 0 : bs * NPG);
    int tid_ = F.wave * 64 + lane_id_v(); const int tid = tid_, w = __builtin_amdgcn_readfirstlane(tid >> 6), lane = tid & 63, g = lane >> 4, li = lane & 15, kg = w & 3, vh = w >> 2; const int srow = SIDE + NMETA + bs;
    LAS unsigned char* qbuf = F.lds + D_QOFF;
    { const int h2 = lane >> 5, nl = lane & 31; const v2u qw = *(const v2u*)(QN + (size_t)srow * D + w * NOPE + 4 * nl);
      const f32x4 qv = {bflo(qw.x), bfhi(qw.x), bflo(qw.y), bfhi(qw.y)};
      const float* wp = w_uk + ((size_t)h2 * HH + w) * NOPE + 4 * nl;
#pragma unroll 1
      for (int i0 = 0; i0 < 128; i0 += 32) { f32x4 wv[32];
#pragma unroll
          for (int i = 0; i < 32; ++i) wv[i] = *(const f32x4*)(wp + (size_t)(i0 + i) * (2 * HH * NOPE));
#pragma unroll
          for (int i = 0; i < 32; ++i) { float p = (qv[0] * wv[i][0] + qv[1] * wv[i][1]) + (qv[2] * wv[i][2] + qv[3] * wv[i][3]); p = scan32(p);
              if (nl == 31) *(LAS bf16*)(qbuf + (w * 320 + 2 * (i0 + i) + h2) * 2) = (bf16)f2bf(p); } } }
    { const int hh = tid >> 6, jj = tid & 63, i = jj >> 1; *(LAS bf16*)(qbuf + (hh * 320 + 256 + ((jj & 1) ? 32 + i : i)) * 2) = QR[(size_t)srow * 512 + hh * ROPE + jj]; }
    for (int i = tid; i < 8 * 320 / 2; i += 512) *(LAS unsigned*)(qbuf + 8 * 640 + 4 * i) = 0u;
    __syncthreads();
    bf16x8 qf[10];
#pragma unroll
    for (int s = 0; s < 10; ++s) qf[s] = *(const LAS bf16x8*)(qbuf + li * 640 + (32 * s + 8 * g) * 2);
    f32x4 o[8]; float mrun = NEG, lrun = 0.f;
#pragma unroll
    for (int vb = 0; vb < 8; ++vb) o[vb] = (f32x4){0.f, 0.f, 0.f, 0.f};
    const float rs_new = rstd_of(ss_get(ssc, srow), 1.f / KVL);
    constexpr int NT = 2 * NPG + 1; const int t0 = sp * 64 + (sp > 0 ? 1 : 0), t1 = (sp + 1) * 64 + 1;
    const unsigned offc = (unsigned)((tid >> 6) * KVL + 4 * (tid & 63)) * 4u, offr = (unsigned)((tid >> 4) * ROPE + 4 * (tid & 15)) * 4u;
    const unsigned ldc = (unsigned)((tid >> 6) * D_KS + (tid & 63) * 8), ldr = (unsigned)((tid >> 4) * D_KS + 512 + (tid & 15) * 8);
    DRegs RA, RB;
#define D_LOAD(R, t_) do { if ((t_) < 2 * NPG) { const int pg_ = __builtin_amdgcn_readfirstlane(ptab[(t_) >> 1]); const size_t row0_ = (size_t)pg_ * PAGE + ((t_) & 1) * 64; \
            const char* cb_ = cache_ckv + row0_ * (KVL * 4); const char* rb_ = cache_kr + row0_ * (ROPE * 4); \
            _Pragma("unroll") for (int j = 0; j < 8; ++j) R.c[j] = __builtin_nontemporal_load((const f32x4*)(cb_ + (offc + (unsigned)j * 8192u))); \
            _Pragma("unroll") for (int j = 0; j < 2; ++j) R.r[j] = __builtin_nontemporal_load((const f32x4*)(rb_ + (offr + (unsigned)j * 8192u))); \
        } else {   \
            _Pragma("unroll") for (int j = 0; j < 8; ++j) R.c[j] = (f32x4){0.f, 0.f, 0.f, 0.f}; \
            _Pragma("unroll") for (int j = 0; j < 2; ++j) R.r[j] = (f32x4){0.f, 0.f, 0.f, 0.f}; \
            if (tid < 64) R.c[0] = *(const f32x4*)(CKVF + (size_t)srow * KVL + 4 * tid) * rs_new * *(const f32x4*)(kv_gain + 4 * tid); \
            if (tid < 16) R.r[0] = *(const f32x4*)(KRF + (size_t)srow * ROPE + 4 * tid); } } while (0)
#define D_TILE(R, t_) do { const int tt_ = (t_); LAS unsigned char* Kt = F.lds + (tt_ & 1) * D_KT; \
        _Pragma("unroll") for (int j = 0; j < 8; ++j) { v2u wv; wv.x = pk2(R.c[j][0], R.c[j][1]); wv.y = pk2(R.c[j][2], R.c[j][3]); *(LAS v2u*)(Kt + ldc + j * (8 * D_KS)) = wv; } \
        _Pragma("unroll") for (int j = 0; j < 2; ++j) { v2u wv; wv.x = pk2(R.r[j][0], R.r[j][1]); wv.y = pk2(R.r[j][2], R.r[j][3]); *(LAS v2u*)(Kt + ldr + j * (32 * D_KS)) = wv; } \
        ATT_BAR();                                                           \
        if (tt_ + 2 < t1) D_LOAD(R, tt_ + 2);                                \
        f32x4 st = {0.f, 0.f, 0.f, 0.f}; \
        { const unsigned ka_ = (unsigned)(size_t)(Kt + (16 * kg + li) * D_KS + 16 * g); bf16x8 dA[5], dB[5];     \
          _Pragma("unroll") for (int s = 0; s < 5; ++s) asm volatile("ds_read_b128 %0, %1 offset:%2" : "=v"(dA[s]) : "v"(ka_), "i"(64 * s)); \
          _Pragma("unroll") for (int s = 0; s < 5; ++s) asm volatile("ds_read_b128 %0, %1 offset:%2" : "=v"(dB[s]) : "v"(ka_), "i"(64 * (5 + s))); \
          asm volatile("s_waitcnt lgkmcnt(5)" : "+v"(dA[0]), "+v"(dA[1]), "+v"(dA[2]), "+v"(dA[3]), "+v"(dA[4])); \
          _Pragma("unroll") for (int s = 0; s < 5; ++s) st = mfma16(dA[s], qf[s], st); \
          asm volatile("s_waitcnt lgkmcnt(0)" : "+v"(dB[0]), "+v"(dB[1]), "+v"(dB[2]), "+v"(dB[3]), "+v"(dB[4])); \
          _Pragma("unroll") for (int s = 0; s < 5; ++s) st = mfma16(dB[s], qf[5 + s], st); } \
        if (tt_ == NT - 1) { \
            _Pragma("unroll") for (int r = 0; r < 4; ++r) if (16 * kg + 4 * g + r != 0) st[r] = NEG; } \
        const float mx = xg_max(max4(st)); \
        if (__builtin_amdgcn_ballot_w64(mx > mrun) != 0ull) {                \
            const float mnew = fmaxf(mrun, mx), alpha = __builtin_amdgcn_exp2f((mrun - mnew) * ATT_C); mrun = mnew; lrun *= alpha; \
            _Pragma("unroll") for (int vb = 0; vb < 8; ++vb) o[vb] = o[vb] * alpha; } \
        float rs = 0.f; \
        _Pragma("unroll") for (int r = 0; r < 4; ++r) { const float p = __builtin_amdgcn_exp2f((st[r] - mrun) * ATT_C); st[r] = p; rs += p; } \
        lrun += xg_sum(rs); \
        const bf16x8 pf = pack8(st, (f32x4){0.f, 0.f, 0.f, 0.f}); \
        LAS unsigned char* ap = Kt + (16 * kg + 4 * g + (li >> 2)) * D_KS + (128 * vh + 4 * (li & 3)) * 2; \
        { const unsigned va_ = (unsigned)(size_t)ap; s16x4 tv[8];                \
          _Pragma("unroll") for (int vb = 0; vb < 8; ++vb) asm volatile("ds_read_b64_tr_b16 %0, %1 offset:%2" : "=v"(tv[vb]) : "v"(va_), "i"(32 * vb)); \
          asm volatile("s_waitcnt lgkmcnt(0)" : "+v"(tv[0]), "+v"(tv[1]), "+v"(tv[2]), "+v"(tv[3]), "+v"(tv[4]), "+v"(tv[5]), "+v"(tv[6]), "+v"(tv[7])); \
          _Pragma("unroll") for (int vb = 0; vb < 8; ++vb) o[vb] = mfma16(cat4(tv[vb], tv[vb]), pf, o[vb]); } } while (0)
    D_LOAD(RA, t0); D_LOAD(RB, t0 + 1);
#pragma unroll 1
    for (int t = t0; t < t1; t += 2) { D_TILE(RA, t); if (t + 1 < t1) D_TILE(RB, t + 1); }
#undef D_LOAD
#undef D_TILE
    __syncthreads();
    LAS float* cm = (LAS float*)(F.lds);
    LAS float* ml = cm + 8 * 8 * 64 * 4;
    if (kg != 0) {
#pragma unroll
        for (int vb = 0; vb < 8; ++vb) *(LAS f32x4*)(cm + ((w * 8 + vb) * 64 + lane) * 4) = o[vb];
        ml[(w * 64 + lane) * 2] = mrun; ml[(w * 64 + lane) * 2 + 1] = lrun;
    }
    __syncthreads();
    if (kg == 0) {
        float mm = mrun;
#pragma unroll
        for (int k = 1; k < 4; ++k) mm = fmaxf(mm, ml[((w + k) * 64 + lane) * 2]);
        const float e0 = __builtin_amdgcn_exp2f((mrun - mm) * ATT_C); float L = lrun * e0;
#pragma unroll
        for (int vb = 0; vb < 8; ++vb) o[vb] = o[vb] * e0;
#pragma unroll
        for (int k = 1; k < 4; ++k) { const float ek = __builtin_amdgcn_exp2f((ml[((w + k) * 64 + lane) * 2] - mm) * ATT_C); L += ml[((w + k) * 64 + lane) * 2 + 1] * ek;
#pragma unroll
            for (int vb = 0; vb < 8; ++vb) o[vb] += *(const LAS f32x4*)(cm + (((w + k) * 8 + vb) * 64 + lane) * 4) * ek; }
        float* part = wsp<float>(F.ws, WS_PART) + (size_t)(((AFLAGS & 64) ? NS * NSPLIT : 0) + bs * NSPLIT + sp) * PART_STRIDE;
        if (li < 8) {
#pragma unroll
            for (int vb = 0; vb < 8; ++vb) *(f32x4*)(part + li * 256 + 128 * vh + 16 * vb + 4 * g) = o[vb];
            if (vh == 0 && g == 0) { part[2048 + li] = mm; part[2056 + li] = L; }
        }
    }
    __syncthreads();
}
__device__ __forceinline__ void attn_combine_unit(const Frame& F, const Args& A, int bs, int half) {
    const int tid = F.wave * 64 + lane_id_v(); const int srow = SIDE + NMETA + bs; const float* w_uv = A.in[22]; bf16* AO = wsp<bf16>(F.ws, WS_AO);
    const float* part = wsp<float>(F.ws, WS_PART) + (size_t)bs * NSPLIT * PART_STRIDE; LAS float* olat = (LAS float*)F.lds;
#pragma unroll 1
    for (int j = 2 * half; j < 2 * half + 2; ++j) { const int idx = tid + 512 * j, hh = idx >> 8; float mm = NEG;
#pragma unroll
        for (int s = 0; s < NSPLIT; ++s) mm = fmaxf(mm, part[s * PART_STRIDE + 2048 + hh]);
        float L = 0.f, ov = 0.f;
#pragma unroll
        for (int s = 0; s < NSPLIT; ++s) { const float e = __builtin_amdgcn_exp2f((part[s * PART_STRIDE + 2048 + hh] - mm) * ATT_C); L += part[s * PART_STRIDE + 2056 + hh] * e; ov += part[s * PART_STRIDE + idx] * e; }
        olat[idx] = ov / L; }
    __syncthreads();
    { const int idx = tid + 512 * half, hh = idx >> 7, v = idx & 127; float s0 = 0.f, s1 = 0.f; const float* wp = w_uv + (size_t)hh * VD + v; const LAS float* ol = olat + hh * 256;
#pragma unroll 1
      for (int r0 = 0; r0 < KVL; r0 += 32) { float wv[32];
#pragma unroll
          for (int r = 0; r < 32; ++r) wv[r] = wp[(size_t)(r0 + r) * (HH * VD)];
#pragma unroll
          for (int r = 0; r < 32; r += 2) { s0 += ol[r0 + r] * wv[r]; s1 += ol[r0 + r + 1] * wv[r + 1]; } }
      AO[(size_t)srow * D + hh * VD + v] = (bf16)f2bf(s0 + s1); }
    __syncthreads();
}
#define SSRD(i_) (SSR{SSPm + (size_t)(i_) * MAIN * 16, SSPs + (size_t)(i_) * 256 * 64})
#define SSWR(i_) (SSW{SSPm + (size_t)(i_) * MAIN * 16, SSPs + (size_t)(i_) * 256 * 64})
constexpr int NPH = 26;
__global__ void __launch_bounds__(512, 2) yoco_fwd(Args A) {
    extern __shared__ __attribute__((aligned(16))) unsigned char lds_raw[];
    Frame F0; F0.lds = (LAS unsigned char*)lds_raw; F0.wave = __builtin_amdgcn_readfirstlane((int)threadIdx.x >> 6);
    F0.G = gridDim.x; F0.bid = blockIdx.x; F0.ws = A.ws; F0.out = A.out;
    volatile LAS unsigned* MISC = (volatile LAS unsigned*)(F0.lds + LDSCTL_OFF);
    if (threadIdx.x < 64) MISC[threadIdx.x] = 0u;
    __syncthreads();
    const bool fused = PROBE_BUILD ? (A.ph_hi - A.ph_lo) > 1 : true;
    XcdBarrier bar; bar.bar = (unsigned*)(A.ws + WS_CTL) + 4096; bar.x = 0; bar.st = MISC + 8;
    if (fused) bar = xcd_barrier_post((unsigned*)(A.ws + WS_CTL) + 4096, MISC + 8);
    int ph = 0; (void)ph;
#ifndef EN_MASK
#define EN_MASK 0xFFFF
#endif
#ifndef REPEAT_MASK
#define REPEAT_MASK 0ull
#endif
#ifndef PROBE_BUILD
#define PROBE_BUILD 0
#endif
#if PROBE_BUILD
#define PHASE_BEGIN(k) if (ph >= A.ph_lo && ph < A.ph_hi) { if constexpr ((EN_MASK >> (k)) & 1) { Frame F = F0; { GAS unsigned char* wg_ = (GAS unsigned char*)F.ws; GAS float* og_ = (GAS float*)F.out; asm volatile("" : "+s"(wg_), "+s"(og_), "+s"(F.G), "+s"(F.bid), "+s"(F.wave)); F.ws = (unsigned char*)wg_; F.out = (float*)og_; }     \
    float* SSPm = wsp<float>(F.ws, WS_SSP); float* SSPs = wsp<float>(F.ws, WS_SSPS); bf16* HB = wsp<bf16>(F.ws, WS_HB); const float* rope = wsp<float>(F.ws, WS_ROPE); (void)SSPm; (void)SSPs; (void)HB; (void)rope;
#define PHASE_END } if (ph + 1 < A.ph_hi) { XcdBarrier b_ = bar; { GAS unsigned* bg_ = (GAS unsigned*)b_.bar; asm volatile("" : "+s"(bg_), "+s"(b_.x)); b_.bar = (unsigned*)bg_; } xcd_barrier(b_); } } ++ph;
#define PHASE_END_LAST } } ++ph;
#else
#define PHASE_BEGIN(k) { { Frame F = F0; { GAS unsigned char* wg_ = (GAS unsigned char*)F.ws; GAS float* og_ = (GAS float*)F.out; asm volatile("" : "+s"(wg_), "+s"(og_), "+s"(F.G), "+s"(F.bid), "+s"(F.wave)); F.ws = (unsigned char*)wg_; F.out = (float*)og_; }     \
    float* SSPm = wsp<float>(F.ws, WS_SSP); float* SSPs = wsp<float>(F.ws, WS_SSPS); bf16* HB = wsp<bf16>(F.ws, WS_HB); const float* rope = wsp<float>(F.ws, WS_ROPE); (void)SSPm; (void)SSPs; (void)HB; (void)rope;
#define PHASE_END } { XcdBarrier b_ = bar; { GAS unsigned* bg_ = (GAS unsigned*)b_.bar; asm volatile("" : "+s"(bg_), "+s"(b_.x)); b_.bar = (unsigned*)bg_; } xcd_barrier(b_); } }
#define PHASE_END_LAST } }
#endif

    PHASE_BEGIN(0) p0_prologue(F, A); PHASE_END

#pragma unroll 1
    for (int l = 0; l < 4; ++l) {
        if (l < 2) {
            PHASE_BEGIN(1)
                pg8::Gemm g{HB, wsp<bf16>(F.ws, WS_WIN) + (size_t)l * 4096 * 1024, MAIN, 4096, D}; pg8::StaticOrder S; S.init(MAIN, 4096, F.G, F.bid);
                epi::HgIn E{SSRD(2 * l), wsp<bf16>(F.ws, WS_QB), wsp<bf16>(F.ws, WS_KB), wsp<bf16>(F.ws, WS_VB), wsp<bf16>(F.ws, WS_GB), wsp<float>(F.ws, WS_LF), wsp<float>(F.ws, WS_LBT) + l * 3072};
                if (!(AFLAGS & 4)) epi::side_gemm(F, g.A, g.Bt, g.N, g.K, E); if (!(AFLAGS & 8)) { const epi::Big<epi::HgIn> BE{E}; pg8::gemm_phase<epi::Big<epi::HgIn>, pg8::StaticOrder, true, true>(F.lds, g, S, BE, F.wave); }
            PHASE_END
            PHASE_BEGIN(2)
                if (F.G >= 2) { const int half = F.G / 2;
                    if (F.bid < half) { if (AFLAGS & 1) for (int u = F.bid; u < NB * HH; u += half) hg_prompt_unit(F, l, u); }
                    else { if (AFLAGS & 2) { for (int u = F.bid - half; u < NS * HH; u += F.G - half) hg_sample_unit(F, A.in[2], l, u);
                            __syncthreads(); const int lane_ = lane_id_v(); convert_weights(F, A, l == 0 ? TD_P0 : TD_R0, l == 0 ? TD_R0 : TD_ITEMS, (F.bid - half) * 8 + F.wave, (F.G - half) * 8, (LAS float*)(F.lds + F.wave * 16384), lane_); } } }
                else { for (int u = 0; u < NB * HH; ++u) hg_prompt_unit(F, l, u); for (int u = 0; u < NS * HH; ++u) hg_sample_unit(F, A.in[2], l, u);
                    __syncthreads(); const int lane_ = lane_id_v(); convert_weights(F, A, l == 0 ? TD_P0 : TD_R0, l == 0 ? TD_R0 : TD_ITEMS, F.wave, 8, (LAS float*)(F.lds + F.wave * 16384), lane_); }
            PHASE_END
        } else {
            const int j = l - 2;
            if (j == 1) {
                PHASE_BEGIN(4)
                    pg8::Gemm g{HB, wsp<bf16>(F.ws, WS_WDQ1), MAIN, 512, D}; pg8::StaticOrder S; S.init(MAIN, 512, F.G, F.bid);
                    epi::Dq E{SSRD(6), wsp<bf16>(F.ws, WS_CQB), SSWR(SS_CQ1)};
                    if (!(AFLAGS & 4)) epi::side_gemm(F, g.A, g.Bt, g.N, g.K, E); if (!(AFLAGS & 8)) { const epi::Big<epi::Dq> BE{E}; pg8::gemm_phase<epi::Big<epi::Dq>, pg8::StaticOrder, true, true>(F.lds, g, S, BE, F.wave); }
                PHASE_END
            }
            if (j == 1) {
                PHASE_BEGIN(5)
                pg8::Gemm g{wsp<bf16>(F.ws, WS_CQB), wsp<bf16>(F.ws, WS_WUQ) + (size_t)j * 1536 * QL, MAIN, 1536, QL}; pg8::StaticOrder S; S.init(MAIN, 1536, F.G, F.bid);
                epi::Uq E{SSRD(SS_CQ0 + j), wsp<bf16>(F.ws, WS_QN), wsp<bf16>(F.ws, WS_QR), rope};
                if (!(AFLAGS & 4)) epi::side_gemm(F, g.A, g.Bt, g.N, g.K, E); if (!(AFLAGS & 8)) { const epi::Big<epi::Uq> BE{E}; pg8::gemm_phase<epi::Big<epi::Uq>, pg8::StaticOrder, true, true>(F.lds, g, S, BE, F.wave); }
                PHASE_END
            }
            PHASE_BEGIN(6)
                gu32* qctr = (gu32*)(A.ws + WS_CTL) + 8192 + 64 * (j + ((AFLAGS & 32) ? 2 : 0)); volatile LAS int* qslot = (volatile LAS int*)(F.lds + LDSCTL_OFF + 128);
                for (;;) {
                    if (F.wave == 0 && lane_id_v() == 0) *qslot = (int)__hip_atomic_fetch_add(qctr, 1u, __ATOMIC_RELAXED, __HIP_MEMORY_SCOPE_AGENT);
                    __syncthreads();
                    const int idx = __builtin_amdgcn_readfirstlane(*qslot);
                    __syncthreads();
                    if (idx >= 1288) break;
                    if (idx < 512 && (idx & 1)) { if (AFLAGS & 2) attn_decode_unit(F, A, idx >> 2, (idx >> 1) & 1); }
                    else if (AFLAGS & 1) { const bool meta = idx >= 1280; const int pi = idx < 512 ? (idx >> 1) : idx - 256; const int bh = pi & 127, qb = 7 - (pi >> 7);
                        attn_prefill_unit(F, meta ? AttnUnit{0, idx - 1280, 0, 1} : AttnUnit{bh >> 3, bh & 7, qb, 0}); }
                }
            PHASE_END
            PHASE_BEGIN(13)
                for (int n = F.bid; n < 2 * NS; n += F.G) attn_combine_unit(F, A, n >> 1, n & 1);
            PHASE_END
        }
        PHASE_BEGIN(7)
            pg8::Gemm g{l < 2 ? wsp<bf16>(F.ws, WS_OB) : wsp<bf16>(F.ws, WS_AO), l < 2 ? wsp<bf16>(F.ws, WS_WHO) + (size_t)l * D * D : wsp<bf16>(F.ws, WS_WO) + (size_t)(l - 2) * D * D, MAIN, D, D};
            pg8::StaticOrder S; S.init(MAIN, D, F.G, F.bid);
            if (l == 0) { const epi::ResT<true> E{A.in[0], HB, SSWR(2 * l + 1), AFLAGS & 16, A.in[6], A.in[1]};
                if (!(AFLAGS & 4)) epi::side_gemm(F, g.A, g.Bt, g.N, g.K, E); if (!(AFLAGS & 8)) { const epi::Big<epi::ResT<true>> BE{E}; pg8::gemm_phase<epi::Big<epi::ResT<true>>, pg8::StaticOrder, true, true>(F.lds, g, S, BE, F.wave); } }
            else { const epi::ResT<false> E{nullptr, HB, SSWR(2 * l + 1), AFLAGS & 16, nullptr, nullptr};
                if (!(AFLAGS & 4)) epi::side_gemm(F, g.A, g.Bt, g.N, g.K, E); if (!(AFLAGS & 8)) { const epi::Big<epi::ResT<false>> BE{E}; pg8::gemm_phase<epi::Big<epi::ResT<false>>, pg8::StaticOrder, true, true>(F.lds, g, S, BE, F.wave); } }
        PHASE_END
        PHASE_BEGIN(8)
            pg8::Gemm g{HB, wsp<bf16>(F.ws, WS_WUP) + (size_t)l * FF * D, MAIN, FF, D}; pg8::StaticOrder S; S.init(MAIN, FF, F.G, F.bid);
            epi::Up E{SSRD(2 * l + 1), wsp<bf16>(F.ws, WS_HID)};
            if (!(AFLAGS & 4)) epi::side_gemm(F, g.A, g.Bt, g.N, g.K, E); if (!(AFLAGS & 8)) { const epi::Big<epi::Up> BE{E}; pg8::gemm_phase<epi::Big<epi::Up>, pg8::StaticOrder, true, true>(F.lds, g, S, BE, F.wave); }
        PHASE_END
        PHASE_BEGIN(9)
            pg8::Gemm g{wsp<bf16>(F.ws, WS_HID), wsp<bf16>(F.ws, WS_WDN) + (size_t)l * FF * D, MAIN, D, FF}; pg8::StaticOrder S; S.init(MAIN, D, F.G, F.bid);
            const epi::ResT<false> E{nullptr, HB, SSWR(2 * l + 2), AFLAGS & 16, nullptr, nullptr};
            if (!(AFLAGS & 4)) epi::side_gemm(F, g.A, g.Bt, g.N, g.K, E); if (!(AFLAGS & 8)) { const epi::Big<epi::ResT<false>> BE{E}; pg8::gemm_phase<epi::Big<epi::ResT<false>>, pg8::StaticOrder, true, true>(F.lds, g, S, BE, F.wave); }
        PHASE_END
        if (l == 1) {
            PHASE_BEGIN(10)
                pg8::Gemm g{HB, wsp<bf16>(F.ws, WS_WKVQ), MAIN, 768, D}; pg8::StaticOrder S; S.init(MAIN, 768, F.G, F.bid);
                epi::KvQ E{SSRD(4), wsp<float>(F.ws, WS_CKVF), wsp<bf16>(F.ws, WS_CKVB), wsp<float>(F.ws, WS_KRF), wsp<bf16>(F.ws, WS_KRB), wsp<bf16>(F.ws, WS_CQB), SSWR(SS_CKV), SSWR(SS_CQ0), rope};
                if (!(AFLAGS & 4)) epi::side_gemm(F, g.A, g.Bt, g.N, g.K, E); if (!(AFLAGS & 8)) { const epi::Big<epi::KvQ> BE{E}; pg8::gemm_phase<epi::Big<epi::KvQ>, pg8::StaticOrder, true, true>(F.lds, g, S, BE, F.wave); }
            PHASE_END
            PHASE_BEGIN(11)
                pg8::Gemm g{wsp<bf16>(F.ws, WS_CKVB), wsp<bf16>(F.ws, WS_WUKV), MAIN, 2048, KVL}; pg8::StaticOrder S; S.init(MAIN, 2048, F.G, F.bid);
                epi::KvUp E{SSRD(SS_CKV), wsp<bf16>(F.ws, WS_KN), wsp<bf16>(F.ws, WS_VV)};
                if (!(AFLAGS & 4)) epi::side_gemm(F, g.A, g.Bt, g.N, g.K, E); if (!(AFLAGS & 8)) { const epi::Big<epi::KvUp> BE{E}; pg8::gemm_phase<epi::Big<epi::KvUp>, pg8::StaticOrder, true, true>(F.lds, g, S, BE, F.wave); }
                kv_outputs(F, A.in[19]);
                pg8::Gemm g2{wsp<bf16>(F.ws, WS_CQB), wsp<bf16>(F.ws, WS_WUQ) + (size_t)0 * 1536 * QL, MAIN, 1536, QL}; pg8::StaticOrder S2; S2.init(MAIN, 1536, F.G, F.bid);
                epi::Uq E2{SSRD(SS_CQ0 + 0), wsp<bf16>(F.ws, WS_QN), wsp<bf16>(F.ws, WS_QR), rope};
                if (!(AFLAGS & 4)) epi::side_gemm(F, g2.A, g2.Bt, g2.N, g2.K, E2); if (!(AFLAGS & 8)) { const epi::Big<epi::Uq> BE2{E2}; pg8::gemm_phase<epi::Big<epi::Uq>, pg8::StaticOrder, true, true>(F.lds, g2, S2, BE2, F.wave); }
            PHASE_END
        }
    }
    PHASE_BEGIN(12) final_norm(F, A.in[9]); PHASE_END_LAST
}

#ifndef REPEAT_FLAGS
#define REPEAT_FLAGS 3
#endif
#ifndef N_LAUNCH_MODE
#define N_LAUNCH_MODE 1
#endif
extern "C" void kernel_launch(void* const* d_in, const int* in_sizes, int n_in, void* d_out, int out_size, void* d_ws, size_t ws_size, hipStream_t stream) {
    static int grid = 0;
    if (grid == 0) {
        if (n_in != 29 || out_size != (int)O_END || ws_size < WS_END) { fprintf(stderr, "kernel_launch: unexpected shapes (n_in %d, out %d, ws %zu < %zu)\n", n_in, out_size, ws_size, (size_t)WS_END); grid = -1; return; }
        int dev = 0, cus = 0, per_cu = 0;
        if (hipGetDevice(&dev) != hipSuccess || hipDeviceGetAttribute(&cus, hipDeviceAttributeMultiprocessorCount, dev) != hipSuccess) { grid = -1; return; }
        if (hipFuncSetAttribute((const void*)yoco_fwd, hipFuncAttributeMaxDynamicSharedMemorySize, LDS_BYTES) != hipSuccess) { fprintf(stderr, "kernel_launch: hipFuncSetAttribute failed\n"); grid = -1; return; }
        if (hipOccupancyMaxActiveBlocksPerMultiprocessor(&per_cu, (const void*)yoco_fwd, 512, LDS_BYTES) != hipSuccess || per_cu < 1) fprintf(stderr, "kernel_launch: occupancy query says %d\n", per_cu);
        (void)hipGetLastError();
        grid = cus;
    }
    if (grid < 0) return;
    (void)hipMemsetAsync((char*)d_ws + WS_CTL, 0, CTL_BYTES, stream);
    Args a{};
    for (int i = 0; i < 29; ++i) a.in[i] = (const float*)d_in[i];
    a.out = (float*)d_out; a.ws = (unsigned char*)d_ws; a.flags = 3;
    if (N_LAUNCH_MODE == 1) { a.ph_lo = 0; a.ph_hi = NPH; hipLaunchKernelGGL(yoco_fwd, dim3(grid), dim3(512), LDS_BYTES, stream, a); }
    else for (int p = 0; p < NPH; ++p) { a.ph_lo = p; a.ph_hi = p + 1; const int reps = ((REPEAT_MASK >> p) & 1ull) ? 2 : 1;
        for (int r = 0; r < reps; ++r) { a.flags = r ? REPEAT_FLAGS : 3; static_assert(PROBE_BUILD || N_LAUNCH_MODE == 1, "multi-launch needs PROBE_BUILD"); hipLaunchKernelGGL(yoco_fwd, dim3(grid), dim3(512), LDS_BYTES, stream, a); } }
}
```
